# Optimizing an MI355X kernel written in HIP

```python
import math
import jax, jax.numpy as jnp
from jax import lax
import numpy as np

D_MODEL = 1024
BATCH = 4
SEQ = 8192
DEPTH = 2

D_FF = 2816
EPS = 1e-6
N_EVEN = (DEPTH + 1) // 2
N_ODD = DEPTH // 2

GLA_HEADS = 4
GLA_VAL = D_MODEL // 2
GLA_DV = GLA_VAL // GLA_HEADS
GLA_DK = GLA_DV // 2
GLA_KEY = GLA_HEADS * GLA_DK
GLA_GATE_RANK = 16
GLA_TAU = 16.0
GLA_CHUNK = 64

POOL_WINDOWS = (2, 4, 8, 16)
POOL_GROUPS = 4
POOL_WIDTH = D_MODEL // 2
POOL_GDIM = POOL_WIDTH // POOL_GROUPS
IN0_WIDTH = 2 * GLA_KEY + 2 * GLA_VAL + GLA_GATE_RANK + POOL_WIDTH

NSA_HDIM = 64
NSA_HEADS = D_MODEL // NSA_HDIM
NSA_KV_GROUPS = 2
NSA_HPG = NSA_HEADS // NSA_KV_GROUPS
NSA_KV = NSA_KV_GROUPS * NSA_HDIM
CMP_BLOCK = 32
CMP_STRIDE = 16
CMP_HIDDEN = 256
SLC_BLOCK = 64
SLC_TOP = 16
WINDOW = 512
Q_BLOCK = 128
IN1_WIDTH = NSA_HEADS * NSA_HDIM + 6 * NSA_KV + 3 * NSA_HEADS
NEG = -1e30
FORCE = 1e4

kernel_name = "hybrid_gla_pool_nsa_macaron"


def rmsnorm(x, g):
    xf = x.astype(jnp.float32)
    y = xf * lax.rsqrt(jnp.mean(xf * xf, axis=-1, keepdims=True) + EPS)
    return (y * g.astype(jnp.float32)).astype(x.dtype)


def swiglu(x, wg, wu, wd):
    return (jax.nn.silu(x @ wg) * (x @ wu)) @ wd


def alibi_slopes(n):
    return np.array([2.0 ** (-8.0 * (i + 1) / n) for i in range(n)], dtype=np.float32)


def gla_chunked(q, k, v, log_a):
    B, T, H, dk = q.shape
    dv = v.shape[-1]
    C = GLA_CHUNK
    N = T // C

    def chunks(z):
        return z.reshape(B, N, C, H, z.shape[-1]).transpose(0, 3, 1, 2, 4)

    q, k, v, log_a = chunks(q * dk ** -0.5), chunks(k), chunks(v), chunks(log_a)
    b = jnp.cumsum(log_a, axis=3)
    b_last = b[:, :, :, -1:, :]
    q_dec = q * jnp.exp(b)
    k_inv = k * jnp.exp(-b)
    k_end = k * jnp.exp(b_last - b)
    causal = jnp.tril(jnp.ones((C, C), dtype=bool))
    att = jnp.where(causal, jnp.einsum('bhnid,bhnjd->bhnij', q_dec, k_inv), 0.0)
    o_intra = jnp.einsum('bhnij,bhnjv->bhniv', att, v)
    d_state = jnp.einsum('bhncd,bhncv->nbhdv', k_end, v)
    chunk_decay = jnp.exp(jnp.moveaxis(b_last[:, :, :, 0, :], 2, 0))

    def step(S, inp):
        dS, dec = inp
        return dec[..., None] * S + dS, S

    _, s_prev = lax.scan(step, jnp.zeros((B, H, dk, dv), q.dtype), (d_state, chunk_decay))
    o_inter = jnp.einsum('bhncd,nbhdv->bhncv', q_dec, s_prev)
    return (o_intra + o_inter).transpose(0, 2, 3, 1, 4).reshape(B, T, H, dv)


def pool_mixer(p, pool_w, pool_scale):
    B, T, _ = p.shape
    pf = p.astype(jnp.float32).reshape(B, T, POOL_GROUPS, POOL_GDIM)
    csum = jnp.cumsum(pf, axis=1)
    tpos = jnp.arange(T)
    groups = []
    for g, w in enumerate(POOL_WINDOWS):
        c = csum[:, :, g]
        c_lag = jnp.pad(c, ((0, 0), (w, 0), (0, 0)))[:, :T]
        cnt = jnp.minimum(tpos + 1, w).astype(jnp.float32)[None, :, None]
        groups.append((c - c_lag) / cnt - pf[:, :, g])
    pooled = jnp.stack(groups, axis=2)
    out = jnp.einsum('btgc,gcd->btgd', pooled, pool_w.astype(jnp.float32))
    return out.reshape(B, T, POOL_WIDTH) * pool_scale.astype(jnp.float32)


def mixer_gla_pool(h, w_in, gate_w2, gate_b, gla_norm, pool_w, pool_scale, w_out):
    B, T, _ = h.shape
    proj = h @ w_in
    cuts = np.cumsum([GLA_KEY, GLA_KEY, GLA_VAL, GLA_VAL, GLA_GATE_RANK]).tolist()
    q, k, v, g, gr, p = jnp.split(proj, cuts, axis=-1)
    f32 = jnp.float32
    log_a = jax.nn.log_sigmoid((gr @ gate_w2 + gate_b).astype(f32)) / GLA_TAU
    o = gla_chunked(q.astype(f32).reshape(B, T, GLA_HEADS, GLA_DK),
                    k.astype(f32).reshape(B, T, GLA_HEADS, GLA_DK),
                    v.astype(f32).reshape(B, T, GLA_HEADS, GLA_DV),
                    log_a.reshape(B, T, GLA_HEADS, GLA_DK))
    o = o * lax.rsqrt(jnp.mean(o * o, axis=-1, keepdims=True) + EPS) * gla_norm.astype(f32)
    o = o * jax.nn.silu(g.astype(f32).reshape(B, T, GLA_HEADS, GLA_DV))
    o_a = o.reshape(B, T, GLA_VAL)
    o_b = pool_mixer(p, pool_w, pool_scale)
    return jnp.concatenate([o_a, o_b], axis=-1).astype(h.dtype) @ w_out


def cmp_to_slc_matrix(ncmp, nslc):
    cs = np.arange(ncmp) * CMP_STRIDE
    ss = np.arange(nslc) * SLC_BLOCK
    ov = np.minimum(cs[:, None] + CMP_BLOCK, ss[None] + SLC_BLOCK) - np.maximum(cs[:, None], ss[None])
    return (np.clip(ov, 0, None) / CMP_BLOCK).astype(np.float32)


def nsa(h, w_in, cmp_pe, cmpk_w1, cmpk_w2, cmpv_w1, cmpv_w2, w_out):
    B, T, _ = h.shape
    G, HPG, dh = NSA_KV_GROUPS, NSA_HPG, NSA_HDIM
    f32 = jnp.float32
    proj = (h @ w_in).astype(f32)
    cuts = (NSA_HEADS * dh + NSA_KV * np.arange(7)).tolist()
    q, kc, vc, ks, vs, kw, vw, gates = jnp.split(proj, cuts, axis=-1)
    q = q.reshape(B, T, G, HPG, dh) * dh ** -0.5
    kc, vc, ks, vs, kw, vw = [z.reshape(B, T, G, dh) for z in (kc, vc, ks, vs, kw, vw)]
    gates = jax.nn.sigmoid(gates.reshape(B, T, G, HPG, 3))

    ncmp = (T - CMP_BLOCK) // CMP_STRIDE + 1
    cidx = np.arange(ncmp)[:, None] * CMP_STRIDE + np.arange(CMP_BLOCK)[None]
    cmp_end = jnp.asarray(cidx[:, -1])

    def compress(z, w1, w2):
        zb = z[:, cidx] + cmp_pe.astype(f32)[None, None, :, None, :]
        zb = zb.transpose(0, 1, 3, 2, 4).reshape(B, ncmp, G, CMP_BLOCK * dh)
        return jax.nn.gelu(zb @ w1) @ w2

    k_cmp = compress(kc, cmpk_w1, cmpk_w2).astype(f32)
    v_cmp = compress(vc, cmpv_w1, cmpv_w2).astype(f32)

    nslc = T // SLC_BLOCK
    n_top = min(SLC_TOP, nslc)
    m_cs = jnp.asarray(cmp_to_slc_matrix(ncmp, nslc))
    k_blk = ks.reshape(B, nslc, SLC_BLOCK, G, dh).transpose(0, 3, 1, 2, 4)
    v_blk = vs.reshape(B, nslc, SLC_BLOCK, G, dh).transpose(0, 3, 1, 2, 4)
    blk_ids = jnp.arange(nslc)
    gather = jax.vmap(jax.vmap(lambda kb, ix: kb[ix]))

    kw_pad = jnp.pad(kw, ((0, 0), (WINDOW, 0), (0, 0), (0, 0)))
    vw_pad = jnp.pad(vw, ((0, 0), (WINDOW, 0), (0, 0), (0, 0)))

    slopes = jnp.asarray(alibi_slopes(NSA_HEADS).reshape(HPG, G).T)

    def block(qb):
        t0 = qb * Q_BLOCK
        qblk = lax.dynamic_slice_in_dim(q, t0, Q_BLOCK, axis=1)
        gblk = lax.dynamic_slice_in_dim(gates, t0, Q_BLOCK, axis=1)
        tpos = t0 + jnp.arange(Q_BLOCK)

        dist_c = tpos[:, None] - cmp_end[None, :]
        valid_c = dist_c >= 0
        s_c = jnp.einsum('bqghd,bngd->bghqn', qblk, k_cmp) - slopes[:, :, None, None] * dist_c
        p_c = jax.nn.softmax(jnp.where(valid_c, s_c, NEG), axis=-1)
        p_c = jnp.where(valid_c.any(-1)[:, None], p_c, 0.0)
        o_c = jnp.einsum('bghqn,bngd->bqghd', p_c, v_cmp)

        imp = jnp.einsum('bghqn,nj->bgqj', p_c, m_cs)
        cur = tpos // SLC_BLOCK
        forced = (blk_ids[None] == 0) | (blk_ids[None] == cur[:, None]) | (blk_ids[None] == cur[:, None] - 1)
        valid_b = (blk_ids[None] * SLC_BLOCK) <= tpos[:, None]
        imp = jnp.where(valid_b, jnp.where(forced, FORCE, imp), -1.0)
        _, sel = lax.top_k(imp, n_top)
        k_sel = gather(k_blk, sel)
        v_sel = gather(v_blk, sel)
        spos = sel[..., None] * SLC_BLOCK + jnp.arange(SLC_BLOCK)
        dist_s = (tpos[None, None, :, None, None] - spos)[:, :, None]
        s_s = jnp.einsum('bqghd,bgqnld->bghqnl', qblk, k_sel) - slopes[None, :, :, None, None, None] * dist_s
        s_s = jnp.where(dist_s >= 0, s_s, NEG)
        sh = s_s.shape
        p_s = jax.nn.softmax(s_s.reshape(sh[:4] + (-1,)), axis=-1).reshape(sh)
        o_s = jnp.einsum('bghqnl,bgqnld->bqghd', p_s, v_sel)

        k_win = lax.dynamic_slice_in_dim(kw_pad, t0, Q_BLOCK + WINDOW, axis=1)
        v_win = lax.dynamic_slice_in_dim(vw_pad, t0, Q_BLOCK + WINDOW, axis=1)
        wpos = t0 - WINDOW + jnp.arange(Q_BLOCK + WINDOW)
        dist_w = tpos[:, None] - wpos[None, :]
        valid_w = (dist_w >= 0) & (dist_w < WINDOW) & (wpos[None, :] >= 0)
        s_w = jnp.einsum('bqghd,bkgd->bghqk', qblk, k_win) - slopes[:, :, None, None] * dist_w
        p_w = jax.nn.softmax(jnp.where(valid_w, s_w, NEG), axis=-1)
        o_w = jnp.einsum('bghqk,bkgd->bqghd', p_w, v_win)

        return gblk[..., 0:1] * o_c + gblk[..., 1:2] * o_s + gblk[..., 2:3] * o_w

    outs = lax.map(block, jnp.arange(T // Q_BLOCK))
    o = outs.transpose(1, 0, 2, 3, 4, 5).reshape(B, T, NSA_HEADS * dh)
    return o.astype(h.dtype) @ w_out


def setup_inputs(seed: int = 0) -> dict:
    key = jax.random.key(seed)
    ks = iter(jax.random.split(key, 40))
    nrm = lambda shape, scale: jax.random.normal(next(ks), shape, jnp.float32) * scale
    gain = lambda shape: 1.0 + nrm(shape, 0.02)
    D, F = D_MODEL, D_FF
    CIN = CMP_BLOCK * NSA_HDIM
    return {
        "x": nrm((BATCH, SEQ, D), 1.0),
        "norm_ffn1": gain((DEPTH, D)),
        "ffn1_wg": nrm((DEPTH, D, F), D ** -0.5),
        "ffn1_wu": nrm((DEPTH, D, F), D ** -0.5),
        "ffn1_wd": nrm((DEPTH, F, D), F ** -0.5),
        "norm_mix": gain((DEPTH, D)),
        "norm_ffn2": gain((DEPTH, D)),
        "ffn2_wg": nrm((DEPTH, D, F), D ** -0.5),
        "ffn2_wu": nrm((DEPTH, D, F), D ** -0.5),
        "ffn2_wd": nrm((DEPTH, F, D), F ** -0.5),
        "a_w_in": nrm((N_EVEN, D, IN0_WIDTH), D ** -0.5),
        "a_gate_w2": nrm((N_EVEN, GLA_GATE_RANK, GLA_KEY), GLA_GATE_RANK ** -0.5),
        "a_gate_b": nrm((N_EVEN, GLA_KEY), 0.1),
        "a_gla_norm": gain((N_EVEN, GLA_DV)),
        "a_pool_w": nrm((N_EVEN, POOL_GROUPS, POOL_GDIM, POOL_GDIM), POOL_GDIM ** -0.5),
        "a_pool_scale": gain((N_EVEN, POOL_WIDTH)),
        "a_w_out": nrm((N_EVEN, D, D), D ** -0.5),
        "c_w_in": nrm((N_ODD, D, IN1_WIDTH), D ** -0.5),
        "c_cmp_pe": nrm((N_ODD, CMP_BLOCK, NSA_HDIM), 0.1),
        "c_cmpk_w1": nrm((N_ODD, CIN, CMP_HIDDEN), CIN ** -0.5),
        "c_cmpk_w2": nrm((N_ODD, CMP_HIDDEN, NSA_HDIM), CMP_HIDDEN ** -0.5),
        "c_cmpv_w1": nrm((N_ODD, CIN, CMP_HIDDEN), CIN ** -0.5),
        "c_cmpv_w2": nrm((N_ODD, CMP_HIDDEN, NSA_HDIM), CMP_HIDDEN ** -0.5),
        "c_w_out": nrm((N_ODD, D, D), D ** -0.5),
        "final_norm": gain((D,)),
    }


def reference(x, norm_ffn1, ffn1_wg, ffn1_wu, ffn1_wd, norm_mix, norm_ffn2, ffn2_wg, ffn2_wu, ffn2_wd,
              a_w_in, a_gate_w2, a_gate_b, a_gla_norm, a_pool_w, a_pool_scale, a_w_out,
              c_w_in, c_cmp_pe, c_cmpk_w1, c_cmpk_w2, c_cmpv_w1, c_cmpv_w2, c_w_out, final_norm):
    h = x
    for l in range(DEPTH):
        h = h + 0.5 * swiglu(rmsnorm(h, norm_ffn1[l]), ffn1_wg[l], ffn1_wu[l], ffn1_wd[l])
        hn = rmsnorm(h, norm_mix[l])
        i = l // 2
        if l % 2 == 0:
            mix = mixer_gla_pool(hn, a_w_in[i], a_gate_w2[i], a_gate_b[i], a_gla_norm[i],
                                 a_pool_w[i], a_pool_scale[i], a_w_out[i])
        else:
            mix = nsa(hn, c_w_in[i], c_cmp_pe[i], c_cmpk_w1[i], c_cmpk_w2[i],
                      c_cmpv_w1[i], c_cmpv_w2[i], c_w_out[i])
        h = h + mix.astype(h.dtype)
        h = h + 0.5 * swiglu(rmsnorm(h, norm_ffn2[l]), ffn2_wg[l], ffn2_wu[l], ffn2_wd[l])
    return rmsnorm(h, final_norm)
```

```cpp
#include <hip/hip_runtime.h>
#include <cstdio>
#include <cstdint>

#ifndef DIAG
#define DIAG 0
#endif
#ifndef MK_ONE_LAUNCH
#define MK_ONE_LAUNCH 1
#endif

namespace pg8 {
#define PG8_LAS __attribute__((address_space(3)))
typedef unsigned short bf16_t;
typedef short bf16x8 __attribute__((ext_vector_type(8)));
typedef float f32x4 __attribute__((ext_vector_type(4)));
typedef unsigned u32x4 __attribute__((ext_vector_type(4)));
constexpr int BM = 256, BK = 64, HALF = 128, HTB = HALF * BK * 2  , STAGE_BYTES = 8 * HTB, NXCD = 8, WGM = 8;

__host__ __device__ __forceinline__ int lds_byte(int r, int c) { const int st = (r >> 4) * 2 + (c >> 5), rr = r & 15, cc = c & 31, ob = rr * 64 + cc * 2; return st * 1024 + (ob ^ (((ob >> 9) & 1) << 5)); }
__host__ __device__ __forceinline__ void stage_rc(int b, int& R, int& C) { const int st = b / 1024, sb = b % 1024, swz = sb ^ (((sb >> 9) & 1) << 5); R = (st >> 1) * 16 + swz / 64; C = (st & 1) * 32 + (swz % 64) / 2; }
__host__ __device__ __forceinline__ int perm32(int rho) { const int n = rho >> 4, i = rho & 15; return 8 * (i >> 2) + 4 * n + (i & 3); }

struct Unit { int pm, pn; };
struct Gemm { const bf16_t* A; const bf16_t* Bt; int K; int lda; int akt; size_t atile; int cmp; int ldb;
    __device__ __forceinline__ size_t aoff(int pm) const {
        if (!cmp) return (size_t)pm * atile;
        const int ksl = pm >> 8, kv = (pm >> 4) & 1, b = (pm >> 2) & 3, gg = (pm >> 1) & 1, half = pm & 1;
        return ((size_t)b * 8192 + (size_t)half * 4096) * 2048 + 1024 + kv * 128 + gg * 64 + (size_t)ksl * 4 * 2048; }
    __device__ __forceinline__ size_t boff(const Unit& u) const { return cmp ? ((size_t)u.pn * 256 * ldb + (size_t)(u.pm >> 8) * 256) : (size_t)u.pn * 256 * ldb; }
};

struct StaticOrder {
    int nM, nN, nwg, G, c;
    __host__ __device__ void init(int M, int N, int G_, int c_) { nM = M / BM; nN = N / BM; nwg = nM * nN; G = G_; c = c_; }
    __host__ __device__ bool next(int i, Unit& u) const {
        const long L = (long)i * G + c; if (L >= nwg) return false;
        int wgid = (int)L; { const int q = nwg / NXCD, r = nwg % NXCD, xcd = wgid % NXCD, off = wgid / NXCD; wgid = (xcd < r ? xcd * (q + 1) : r * (q + 1) + (xcd - r) * q) + off; }
        const int nig = WGM * nN, gid = wgid / nig, fm = gid * WGM, gsz = (nM - fm) < WGM ? (nM - fm) : WGM;
        u.pm = fm + ((wgid % nig) % gsz); u.pn = (wgid % nig) / gsz; return true;
    }
};
struct CmpOrder {
    int G, c;
    __device__ bool next(int i, Unit& u) const { const int L = i * G + c; if (L >= 256) return false; u.pm = (L >> 3) | ((L & 7) << 8); u.pn = L >> 7; return true; }
};

__device__ __forceinline__ unsigned cvt_pk_bf16(float lo, float hi) { unsigned r; asm volatile("v_cvt_pk_bf16_f32 %0, %1, %2" : "=v"(r) : "v"(lo), "v"(hi)); return r; }

template <class Epi, class Sched, bool ALIGN_EPI = true>
__device__ __forceinline__ void gemm_phase(PG8_LAS unsigned char* lds, const Gemm g, const Sched& S, const Epi& E) {
    int tid_ = threadIdx.x; asm volatile("" : "+v"(tid_));
    const int tid = tid_, wid = __builtin_amdgcn_readfirstlane(tid >> 6), lane = tid & 63, wr = wid >> 2, wc = wid & 3, fr = lane & 15, fq = lane >> 4;
    const int K = g.K, nt = K / BK;
    unsigned voffA[2], voffB[2];
#pragma unroll
    for (int i = 0; i < 2; ++i) { int R, C; stage_rc(tid * 16 + i * 8192, R, C); const int Rb = Epi::PERM ? ((R & ~31) + perm32(R & 31)) : R;
        voffA[i] = (unsigned)(R * g.lda + C) * 2u; voffB[i] = (unsigned)(Rb * g.ldb + C) * 2u; }
    const size_t kstepA = (size_t)g.akt * 2, kstepB = (size_t)(BK * 2);
    const size_t hstepA = (size_t)HALF * g.lda * 2, hstepB = (size_t)HALF * g.ldb * 2;
    const unsigned ldsw = (unsigned)wid * 1024u;
    const int aoff = lds_byte(wr * 64 + fr, fq * 8), boff = lds_byte(wc * 32 + fr, fq * 8);
#define PG8_SA(b, h) (((b) * 2 + (h)) * HTB)
#define PG8_SB(b, h) ((4 + (b) * 2 + (h)) * HTB)
#define PG8_STAGE(bufoff, gbase, voff) do { _Pragma("unroll") for (int _i = 0; _i < 2; ++_i) \
        __builtin_amdgcn_global_load_lds((const unsigned*)((const char*)(gbase) + (voff)[_i]), (PG8_LAS unsigned*)(lds + (bufoff) + ldsw + _i * 8192), 16, 0, 0); } while (0)
#define PG8_LDA(dst, b, h) do { _Pragma("unroll") for (int m = 0; m < 4; ++m) _Pragma("unroll") for (int k = 0; k < 2; ++k) dst[m][k] = *(const PG8_LAS bf16x8*)(lds + PG8_SA(b, h) + aoff + m * 2048 + k * 1024); } while (0)
#define PG8_LDB(dst, b, h) do { _Pragma("unroll") for (int n = 0; n < 2; ++n) _Pragma("unroll") for (int k = 0; k < 2; ++k) dst[n][k] = *(const PG8_LAS bf16x8*)(lds + PG8_SB(b, h) + boff + n * 2048 + k * 1024); } while (0)
#define PG8_MMA(ai, bj, At, Bt) do { __builtin_amdgcn_s_setprio(1); _Pragma("unroll") for (int m = 0; m < 4; ++m) _Pragma("unroll") for (int n = 0; n < 2; ++n) _Pragma("unroll") for (int k = 0; k < 2; ++k) \
        acc[ai][bj][m][n] = __builtin_amdgcn_mfma_f32_16x16x32_bf16(Bt[n][k], At[m][k], acc[ai][bj][m][n], 0, 0, 0); __builtin_amdgcn_s_setprio(0); } while (0)
#define PG8_WAIT_V(n) asm volatile("s_waitcnt vmcnt(" #n ")" ::: "memory")
#define PG8_WAIT_L(n) asm volatile("s_waitcnt lgkmcnt(" #n ")" ::: "memory")
#define PG8_BAR __builtin_amdgcn_s_barrier()
#define PG8_SCHED __builtin_amdgcn_sched_barrier(0)
    Unit cur, nxt; int ui = 0;
    if (!S.next(0, cur)) return;
    f32x4 acc[2][2][4][2];
#pragma unroll
    for (int a = 0; a < 2; ++a)
#pragma unroll
        for (int b = 0; b < 2; ++b)
#pragma unroll
            for (int m = 0; m < 4; ++m)
#pragma unroll
                for (int n = 0; n < 2; ++n) acc[a][b][m][n] = (f32x4){0.f, 0.f, 0.f, 0.f};
    bf16x8 At[4][2], B0[2][2], B1[2][2];
    const char* cA = (const char*)g.A + g.aoff(cur.pm) * 2; const char* cB = (const char*)g.Bt + g.boff(cur) * 2;
    if constexpr (Epi::NEEDS_RS) {
        constexpr int MAXU = 12; f32x4 sa[MAXU], sb[MAXU]; bool ok[MAXU];
#pragma unroll
        for (int i = 0; i < MAXU; ++i) { Unit u_; ok[i] = S.next(i, u_); sa[i] = (f32x4){0.f, 0.f, 0.f, 0.f}; sb[i] = sa[i];
            if (ok[i]) { const float* sp_ = E.stats + ((size_t)(u_.pm * BM + (tid >> 1)) * 16 + (tid & 1) * 8); sa[i] = *(const f32x4*)sp_; sb[i] = *(const f32x4*)(sp_ + 4); } }
#pragma unroll
        for (int i = 0; i < MAXU; ++i) if (ok[i]) { float s_ = ((sa[i][0] + sa[i][1]) + (sa[i][2] + sa[i][3])) + ((sb[i][0] + sb[i][1]) + (sb[i][2] + sb[i][3]));
            s_ += __builtin_bit_cast(float, __builtin_amdgcn_mov_dpp(__builtin_bit_cast(int, s_), 0xB1, 0xf, 0xf, true));
            if ((tid & 1) == 0) ((PG8_LAS float*)(E.rs_lds + i * 1024))[tid >> 1] = __builtin_amdgcn_rsqf(s_ * (1.0f / 1024.0f) + 1e-6f); }
    }
    PG8_STAGE(PG8_SB(0, 0), cB, voffB); PG8_STAGE(PG8_SB(0, 1), cB + hstepB, voffB); PG8_STAGE(PG8_SA(0, 0), cA, voffA); PG8_STAGE(PG8_SA(0, 1), cA + hstepA, voffA);
    if (wr == 1) PG8_BAR;
    PG8_WAIT_V(2); PG8_BAR;
    PG8_STAGE(PG8_SB(1, 0), cB + kstepB, voffB); PG8_STAGE(PG8_SA(1, 0), cA + kstepA, voffA); PG8_STAGE(PG8_SB(1, 1), cB + hstepB + kstepB, voffB);
    PG8_WAIT_V(6); PG8_BAR;
    for (;;) {
        const bool has_next = S.next(ui + 1, nxt);
        const char* nA = has_next ? (const char*)g.A + g.aoff(nxt.pm) * 2 : cA; const char* nB = has_next ? (const char*)g.Bt + g.boff(nxt) * 2 : cB;
        for (int t = 0; t < nt; t += 2) {
            const bool last = (t == nt - 2);
            const char* a1 = cA + (size_t)(t + 1) * kstepA;
            const char* a2 = last ? nA : cA + (size_t)(t + 2) * kstepA; const char* b2 = last ? nB : cB + (size_t)(t + 2) * kstepB;
            const char* a3 = a2 + kstepA; const char* b3 = b2 + kstepB;
            PG8_LDB(B0, 0, 0); PG8_LDB(B1, 0, 1); PG8_SCHED; PG8_LDA(At, 0, 0); PG8_STAGE(PG8_SA(1, 1), a1 + hstepA, voffA);
            PG8_WAIT_V(8); PG8_WAIT_L(0); PG8_BAR; PG8_MMA(0, 0, At, B0); PG8_MMA(0, 1, At, B1); PG8_BAR; PG8_SCHED;
            PG8_LDA(At, 0, 1); PG8_STAGE(PG8_SB(0, 0), b2, voffB); PG8_STAGE(PG8_SB(0, 1), b2 + hstepB, voffB); PG8_STAGE(PG8_SA(0, 0), a2, voffA);
            PG8_WAIT_V(8); PG8_WAIT_L(0); PG8_BAR; PG8_MMA(1, 0, At, B0); PG8_MMA(1, 1, At, B1); PG8_BAR; PG8_SCHED;
            PG8_LDB(B0, 1, 0); PG8_LDB(B1, 1, 1); PG8_SCHED; PG8_LDA(At, 1, 0); PG8_STAGE(PG8_SA(0, 1), a2 + hstepA, voffA);
            PG8_WAIT_V(8); PG8_WAIT_L(0); PG8_BAR; PG8_MMA(0, 0, At, B0); PG8_MMA(0, 1, At, B1); PG8_BAR; PG8_SCHED;
            PG8_LDA(At, 1, 1); PG8_STAGE(PG8_SB(1, 0), b3, voffB); PG8_STAGE(PG8_SB(1, 1), b3 + hstepB, voffB); PG8_STAGE(PG8_SA(1, 0), a3, voffA);
            PG8_WAIT_V(8); PG8_WAIT_L(0); PG8_BAR; PG8_MMA(1, 0, At, B0); PG8_MMA(1, 1, At, B1); PG8_BAR; PG8_SCHED;
        }
        if constexpr (ALIGN_EPI) { if (wr == 0) PG8_BAR; }
        E(acc, cur, wr, wc, fr, fq, ui);
        if (!has_next) break;
#pragma unroll
        for (int a = 0; a < 2; ++a)
#pragma unroll
            for (int b = 0; b < 2; ++b)
#pragma unroll
                for (int m = 0; m < 4; ++m)
#pragma unroll
                    for (int n = 0; n < 2; ++n) acc[a][b][m][n] = (f32x4){0.f, 0.f, 0.f, 0.f};
        cur = nxt; cA = nA; cB = nB; ++ui;
        if constexpr (ALIGN_EPI) { if (wr == 1) PG8_BAR; }
    }
    PG8_WAIT_V(0);
    if constexpr (!ALIGN_EPI) { if (wr == 0) PG8_BAR; }
    PG8_BAR;
#undef PG8_SA
#undef PG8_SB
#undef PG8_STAGE
#undef PG8_LDA
#undef PG8_LDB
#undef PG8_MMA
#undef PG8_WAIT_V
#undef PG8_WAIT_L
#undef PG8_BAR
#undef PG8_SCHED
}
}

constexpr int NWAVES = 8, NTHR = 512;
constexpr int Bsz = 4, T = 8192, D = 1024, FF = 2816, M = Bsz * T;
constexpr int N0 = 2304;
constexpr int N1 = 2048;
constexpr float EPS = 1e-6f;
constexpr float LOG2E = 1.4426950408889634f;

constexpr size_t MiB = 1u << 20;
constexpr size_t WS_CTL = 0, CTL_ZERO_BYTES = 1 * MiB;
constexpr size_t WS_STATS = 1 * MiB;
constexpr size_t WS_MISC = 3 * MiB;
constexpr size_t WS_WGU = 4 * MiB;
constexpr size_t WS_WD = 48 * MiB;
constexpr size_t WS_W0IN = 70 * MiB;
constexpr size_t WS_W0OUT = 75 * MiB;
constexpr size_t WS_W1IN = 77 * MiB;
constexpr size_t WS_W1OUT = 81 * MiB;
constexpr size_t WS_WC1 = 83 * MiB;
constexpr size_t WS_HB = 86 * MiB;
constexpr size_t WS_BIG = 150 * MiB;
constexpr size_t WS_X2 = 326 * MiB;
constexpr size_t WS_DECAY = 390 * MiB;
constexpr size_t WS_OCAT = 391 * MiB;
constexpr size_t WS_SPT = 456 * MiB;
constexpr size_t WS_END = 488 * MiB;

constexpr int RING_OFF = 0, RING_BYTES = 131072;
constexpr int RS_OFF = RING_BYTES;
constexpr int LDS_BYTES = 147456;
constexpr int LDSCTL_OFF = LDS_BYTES - 1024, MISC_OFF = LDSCTL_OFF + 320;

#define GAS __attribute__((address_space(1)))
#define LAS __attribute__((address_space(3)))
typedef unsigned short bf16;
typedef unsigned v4u __attribute__((ext_vector_type(4)));
typedef unsigned v2u __attribute__((ext_vector_type(2)));
typedef float f32x4 __attribute__((ext_vector_type(4)));
typedef float f32x16 __attribute__((ext_vector_type(16)));
typedef short bf16x8 __attribute__((ext_vector_type(8)));
typedef GAS unsigned gu32;
#define RLX_AGENT __ATOMIC_RELAXED, __HIP_MEMORY_SCOPE_AGENT
#define LDS_WAIT() asm volatile("s_waitcnt lgkmcnt(0)" ::: "memory")
#define VM_WAIT() asm volatile("s_waitcnt vmcnt(0)" ::: "memory")
__device__ __forceinline__ unsigned f2bf(float f) { unsigned u = __builtin_bit_cast(unsigned, f); return (u + 0x7fffu + ((u >> 16) & 1u)) >> 16; }
__device__ __forceinline__ unsigned pk2(float lo, float hi) { return f2bf(lo) | (f2bf(hi) << 16); }
__device__ __forceinline__ float bf2f(unsigned short b) { return __builtin_bit_cast(float, (unsigned)b << 16); }
__device__ __forceinline__ float bflo(unsigned w) { return __builtin_bit_cast(float, w << 16); }
__device__ __forceinline__ float bfhi(unsigned w) { return __builtin_bit_cast(float, w & 0xffff0000u); }
__device__ __forceinline__ float fast_exp2(float x) { return __builtin_amdgcn_exp2f(x); }
__device__ __forceinline__ float fast_rcp(float x) { return __builtin_amdgcn_rcpf(x); }
__device__ __forceinline__ float sigmoidf_(float x) { return fast_rcp(1.0f + fast_exp2(-x * LOG2E)); }
__device__ __forceinline__ float siluf_(float x) { return x * sigmoidf_(x); }
__device__ __forceinline__ float wave_sum(float v) {
#pragma unroll
    for (int o = 1; o < 64; o <<= 1) v += __shfl_xor(v, o);
    return v;
}

namespace pg8 {
typedef float f32x2v __attribute__((ext_vector_type(2)));
__device__ __forceinline__ void row_scales(const PG8_LAS unsigned char* tab, int wr, int fr, float (&rs)[2][4]) {
#pragma unroll
    for (int ai = 0; ai < 2; ++ai)
#pragma unroll
        for (int m = 0; m < 4; ++m) rs[ai][m] = ((const PG8_LAS float*)tab)[ai * HALF + wr * 64 + m * 16 + fr];
}
struct EpiUp {
    static constexpr bool PERM = true, NEEDS_RS = true;
    bf16_t* H; const float* stats; PG8_LAS unsigned char* rs_lds;
    __device__ __forceinline__ void operator()(const f32x4 (&acc)[2][2][4][2], const Unit& u, int wr, int wc, int fr, int fq, int slot) const {
        const int row0 = u.pm * BM + wr * 64 + fr; const PG8_LAS float* tab = (const PG8_LAS float*)(rs_lds + slot * 1024) + wr * 64 + fr;
        const int col0 = u.pn * 128 + wc * 32 + 8 * fq;
#pragma unroll
        for (int ai = 0; ai < 2; ++ai)
#pragma unroll
            for (int m = 0; m < 4; ++m) { const float s = tab[ai * HALF + m * 16]; float o[8];
                const f32x2v sneg = (f32x2v){-s * LOG2E, -s * LOG2E}, s2 = (f32x2v){s * s, s * s}, one = (f32x2v){1.f, 1.f};
#pragma unroll
                for (int n = 0; n < 2; ++n)
#pragma unroll
                    for (int i = 0; i < 4; i += 2) { const f32x2v gv = (f32x2v){acc[ai][0][m][n][i], acc[ai][0][m][n][i + 1]}, uv = (f32x2v){acc[ai][1][m][n][i], acc[ai][1][m][n][i + 1]};
                        const f32x2v tt = gv * sneg; f32x2v e; e.x = fast_exp2(tt.x); e.y = fast_exp2(tt.y); const f32x2v dd = e + one; f32x2v r; r.x = fast_rcp(dd.x); r.y = fast_rcp(dd.y);
                        const f32x2v res = (gv * uv) * (r * s2); o[n * 4 + i] = res.x; o[n * 4 + i + 1] = res.y;
#ifdef EPI_X
                        { const f32x2v t2 = uv * sneg; f32x2v e2; e2.x = fast_exp2(t2.x); e2.y = fast_exp2(t2.y); const f32x2v d2 = e2 + one; f32x2v r2; r2.x = fast_rcp(d2.x); r2.y = fast_rcp(d2.y); const f32x2v q2 = (gv * uv) * (r2 * s2); asm volatile("" :: "v"(q2.x), "v"(q2.y)); }
#endif
                    }
                u32x4 w; w.x = cvt_pk_bf16(o[0], o[1]); w.y = cvt_pk_bf16(o[2], o[3]); w.z = cvt_pk_bf16(o[4], o[5]); w.w = cvt_pk_bf16(o[6], o[7]);
                *(u32x4*)(H + (size_t)(row0 + ai * HALF + m * 16) * FF + col0) = w; }
    }
};
struct EpiRes {
    static constexpr bool PERM = true, NEEDS_RS = false;
    bf16_t* hb; float* stats; float coef;
    __device__ __forceinline__ void operator()(const f32x4 (&acc)[2][2][4][2], const Unit& u, int wr, int wc, int fr, int fq, int) const {
        const int row0 = u.pm * BM + wr * 64 + fr, col0 = u.pn * BM + wc * 32 + 8 * fq;
        u32x4 rr[2][4][2];
#pragma unroll
        for (int ai = 0; ai < 2; ++ai)
#pragma unroll
            for (int m = 0; m < 4; ++m)
#pragma unroll
                for (int bj = 0; bj < 2; ++bj) rr[ai][m][bj] = *(const u32x4*)(hb + (size_t)(row0 + ai * HALF + m * 16) * D + col0 + bj * HALF);
#pragma unroll
        for (int ai = 0; ai < 2; ++ai)
#pragma unroll
            for (int m = 0; m < 4; ++m) { const int row = row0 + ai * HALF + m * 16; const size_t off = (size_t)row * D + col0; float ss = 0.f;
#pragma unroll
                for (int bj = 0; bj < 2; ++bj) {
                    const u32x4 r = rr[ai][m][bj];
                    const f32x4 r0 = (f32x4){bflo(r.x), bfhi(r.x), bflo(r.y), bfhi(r.y)}, r1 = (f32x4){bflo(r.z), bfhi(r.z), bflo(r.w), bfhi(r.w)};
                    const f32x4 v0 = r0 + acc[ai][bj][m][0] * coef, v1 = r1 + acc[ai][bj][m][1] * coef;
                    u32x4 w; w.x = cvt_pk_bf16(v0[0], v0[1]); w.y = cvt_pk_bf16(v0[2], v0[3]); w.z = cvt_pk_bf16(v1[0], v1[1]); w.w = cvt_pk_bf16(v1[2], v1[3]);
                    *(u32x4*)(hb + off + bj * HALF) = w;
                    ss += (v0[0] * v0[0] + v0[1] * v0[1]) + (v0[2] * v0[2] + v0[3] * v0[3]) + (v1[0] * v1[0] + v1[1] * v1[1]) + (v1[2] * v1[2] + v1[3] * v1[3]); }
                ss += __shfl_xor(ss, 16); ss += __shfl_xor(ss, 32);
                if (fq == 0) stats[(size_t)row * 16 + u.pn * 4 + wc] = ss; }
    }
};
struct EpiProj {
    static constexpr bool PERM = true, NEEDS_RS = true;
    bf16_t* O; int ldc; const float* stats; PG8_LAS unsigned char* rs_lds;
    __device__ __forceinline__ void operator()(const f32x4 (&acc)[2][2][4][2], const Unit& u, int wr, int wc, int fr, int fq, int slot) const {
        const int row0 = u.pm * BM + wr * 64 + fr; const PG8_LAS float* tab = (const PG8_LAS float*)(rs_lds + slot * 1024) + wr * 64 + fr;
        const int col0 = u.pn * BM + wc * 32 + 8 * fq;
#pragma unroll
        for (int ai = 0; ai < 2; ++ai)
#pragma unroll
            for (int m = 0; m < 4; ++m) { const float s = tab[ai * HALF + m * 16]; bf16_t* rowp = O + (size_t)(row0 + ai * HALF + m * 16) * ldc + col0;
#pragma unroll
                for (int bj = 0; bj < 2; ++bj) { const f32x4 v0 = acc[ai][bj][m][0] * s, v1 = acc[ai][bj][m][1] * s;
                    u32x4 w; w.x = cvt_pk_bf16(v0[0], v0[1]); w.y = cvt_pk_bf16(v0[2], v0[3]); w.z = cvt_pk_bf16(v1[0], v1[1]); w.w = cvt_pk_bf16(v1[2], v1[3]);
                    *(u32x4*)(rowp + bj * HALF) = w; } }
    }
};
__device__ __forceinline__ float gelu_tanh_(float x) { const float y = 1.5957691216057308f * (x + 0.044715f * x * x * x); return x * fast_rcp(1.0f + fast_exp2(-y * LOG2E)); }
struct EpiPart {
    static constexpr bool PERM = true, NEEDS_RS = false;
    float* part;
    __device__ __forceinline__ void operator()(const f32x4 (&acc)[2][2][4][2], const Unit& u, int wr, int wc, int fr, int fq, int) const {
        const int row0 = (u.pm & 255) * BM + wr * 64 + fr, col0 = wc * 32 + 8 * fq; float* base = part + (size_t)(u.pm >> 8) * 8192 * 256;
#pragma unroll
        for (int ai = 0; ai < 2; ++ai)
#pragma unroll
            for (int m = 0; m < 4; ++m) { float* rowp = base + (size_t)(row0 + ai * HALF + m * 16) * 256 + col0;
#pragma unroll
                for (int bj = 0; bj < 2; ++bj) { *(f32x4*)(rowp + bj * HALF) = acc[ai][bj][m][0]; *(f32x4*)(rowp + bj * HALF + 4) = acc[ai][bj][m][1]; } }
    }
};
}
#define XB_TMO      128
#define XB_XCNT(j)  (256  + 64 * (j))
#define XB_XSUB(j)  (1280 + 64 * (j))
#define XB_XGEN(j)  (2304 + 64 * (j))
#define XB_TOP      3328
#define XB_TOPGEN   3392
#define XCD_BAR_WORDS 3456
#define XB_SPIN_CAP (1u << 18)

__device__ __forceinline__ unsigned xb_ld(unsigned* p)              { return __hip_atomic_load(p, __ATOMIC_RELAXED, __HIP_MEMORY_SCOPE_AGENT); }
__device__ __forceinline__ unsigned xb_add(unsigned* p, unsigned v) { return __hip_atomic_fetch_add(p, v, __ATOMIC_RELAXED, __HIP_MEMORY_SCOPE_AGENT); }
__device__ __forceinline__ unsigned xb_xcc_id() { return (unsigned)__builtin_amdgcn_s_getreg((3 << 11) | 20) & 0xFu; }
#define XB_SPIN(cond, bar) do { unsigned _sp = 0; while (cond) { __builtin_amdgcn_s_sleep(1); \
    if ((++_sp & 255u) == 0u) { if (xb_ld(&(bar)[XB_TMO])) break; if (_sp > XB_SPIN_CAP) { atomicAdd(&(bar)[XB_TMO], 1u); break; } } } } while (0)

struct XcdBarrier {
    unsigned* bar; unsigned x;
    volatile LAS unsigned* st;
};

__device__ __forceinline__ XcdBarrier xcd_barrier_post(unsigned* bar, volatile LAS unsigned* st) {
    XcdBarrier b; b.bar = bar; b.x = xb_xcc_id(); b.st = st;
    if (threadIdx.x == 0) (void)xb_add(&bar[XB_XCNT(b.x)], 1u);
    return b;
}
__device__ __forceinline__ void xcd_barrier_complete(unsigned* bar, unsigned x, unsigned& nloc, unsigned& nx) {
    const unsigned G = gridDim.x * gridDim.y * gridDim.z;
    unsigned sum, cnt, mine, sp = 0u;
    for (;;) {
        sum = 0u; cnt = 0u; mine = 0u;
#pragma unroll
        for (unsigned j = 0; j < 16; ++j) { const unsigned c = xb_ld(&bar[XB_XCNT(j)]); sum += c; cnt += (c > 0u) ? 1u : 0u; mine = (j == x) ? c : mine; }
        if (sum == G) break;
        __builtin_amdgcn_s_sleep(1);
        if ((++sp & 255u) == 0u) { if (xb_ld(&bar[XB_TMO])) break; if (sp > XB_SPIN_CAP) { atomicAdd(&bar[XB_TMO], 1u); break; } }
    }
    nloc = mine > 0u ? mine : 1u; nx = cnt > 0u ? cnt : 1u;
}

__device__ __forceinline__ void xcd_barrier(const XcdBarrier& b) {
    asm volatile("s_waitcnt vmcnt(0)" ::: "memory");
    __syncthreads();
    if (threadIdx.x == 0) {
        unsigned* bar = b.bar;
        __builtin_amdgcn_s_waitcnt(0);
        unsigned nloc = b.st[0], nx = b.st[1];
        if (nloc == 0u) { xcd_barrier_complete(bar, b.x, nloc, nx); b.st[0] = nloc; b.st[1] = nx; }
        const unsigned old = xb_add(&bar[XB_XSUB(b.x)], 1u);
        const unsigned gen = old / nloc;
        if (old + 1u == (gen + 1u) * nloc) {
            __builtin_amdgcn_fence(__ATOMIC_RELEASE, "agent");
            asm volatile("s_waitcnt vmcnt(0)" ::: "memory");
            const unsigned og = xb_add(&bar[XB_TOP], 1u);
            const unsigned tg = og / nx;
            if (og + 1u == (tg + 1u) * nx) xb_add(&bar[XB_TOPGEN], 1u);
            else XB_SPIN(xb_ld(&bar[XB_TOPGEN]) == tg, bar);
            __builtin_amdgcn_fence(__ATOMIC_ACQUIRE, "agent");
            xb_add(&bar[XB_XGEN(b.x)], 1u);
            asm volatile("s_waitcnt vmcnt(0)" ::: "memory");
        } else {
            XB_SPIN(xb_ld(&bar[XB_XGEN(b.x)]) == gen, bar);
            __builtin_amdgcn_fence(__ATOMIC_ACQUIRE, "agent");
            asm volatile("s_waitcnt vmcnt(0)" ::: "memory");
        }
    }
    __syncthreads();
}

struct Ptrs {
    const float* x; const float* norm_ffn1; const float* ffn1_wg; const float* ffn1_wu; const float* ffn1_wd; const float* norm_mix; const float* norm_ffn2;
    const float* ffn2_wg; const float* ffn2_wu; const float* ffn2_wd; const float* a_w_in; const float* a_gate_w2; const float* a_gate_b; const float* a_gla_norm;
    const float* a_pool_w; const float* a_pool_scale; const float* a_w_out; const float* c_w_in; const float* c_cmp_pe; const float* c_cmpk_w1; const float* c_cmpk_w2;
    const float* c_cmpv_w1; const float* c_cmpv_w2; const float* c_w_out; const float* final_norm;
    float* out; unsigned char* ws; int ph_lo, ph_hi;
};
struct Frame {
    LAS unsigned char* lds;
    int tid, lane, wave, vcu, G;
};

__device__ __forceinline__ void transpose_item(const float* W, int ldw, int col0, int K, int nvalid, const float* gain, float coef, bf16* WT, int drow0, int mode,
                                               LAS float* scr, int item, int nblk, int lane) {
    const int kb = item / nblk, nb = item % nblk, k0 = 64 * kb, n0 = 32 * nb;
    const int nn = lane & 31; const bool ok = (n0 + nn) < nvalid;
    float v[32];
    const float* src = W + (size_t)(k0 + (lane >> 5)) * ldw + col0 + n0 + (ok ? nn : 0);
#pragma unroll
    for (int i = 0; i < 32; ++i) v[i] = src[(size_t)(2 * i) * ldw];
    if (gain) {
#pragma unroll
        for (int i = 0; i < 32; ++i) v[i] *= gain[k0 + 2 * i + (lane >> 5)];
    }
#pragma unroll
    for (int i = 0; i < 32; ++i) scr[(2 * i + (lane >> 5)) * 33 + nn] = ok ? v[i] * coef : 0.f;
    LDS_WAIT(); asm volatile("" ::: "memory");
    const int c = lane & 7;
    int dbase = drow0 + n0; if (mode == 1) dbase = drow0 + (n0 >> 7) * 256 + (n0 & 127); else if (mode == 2) dbase = drow0 + (n0 >> 7) * 256 + 128 + (n0 & 127);
#pragma unroll
    for (int j = 0; j < 4; ++j) { const int n = (lane >> 3) + 8 * j; const LAS float* s = scr + (8 * c) * 33 + n;
        v4u o; o.x = pk2(s[0 * 33], s[1 * 33]); o.y = pk2(s[2 * 33], s[3 * 33]); o.z = pk2(s[4 * 33], s[5 * 33]); o.w = pk2(s[6 * 33], s[7 * 33]);
        *(GAS v4u*)(WT + (size_t)(dbase + n) * K + k0 + 8 * c) = o; }
    LDS_WAIT(); asm volatile("" ::: "memory");
}
struct TJob { const float* W; int ldw, col0, K, ncols, nvalid; const float* gain; float coef; bf16* WT; int drow0, mode; };
__device__ __forceinline__ void get_job(const Ptrs& P, int id, TJob& j) {
    unsigned char* ws = P.ws;
    j.col0 = 0; j.gain = nullptr; j.coef = 1.f; j.drow0 = 0; j.mode = 0;
    if (id < 8) {
        const int idx = id & 3, l = idx >> 1, f = idx & 1; const bool up = id >= 4;
        j.W = (f == 0 ? (up ? P.ffn1_wu : P.ffn1_wg) : (up ? P.ffn2_wu : P.ffn2_wg)) + (size_t)l * D * FF; j.ldw = FF; j.K = D; j.ncols = FF; j.nvalid = FF;
        j.gain = (f == 0 ? P.norm_ffn1 : P.norm_ffn2) + l * D; j.WT = (bf16*)(ws + WS_WGU) + (size_t)idx * (2 * FF) * D; j.mode = up ? 2 : 1;
    } else if (id < 12) {
        const int idx = id - 8, l = idx >> 1, f = idx & 1;
        j.W = (f == 0 ? P.ffn1_wd : P.ffn2_wd) + (size_t)l * FF * D; j.ldw = D; j.K = FF; j.ncols = D; j.nvalid = D; j.WT = (bf16*)(ws + WS_WD) + (size_t)idx * D * FF;
    } else if (id == 12) {
        j.W = P.a_w_in; j.ldw = 2064; j.K = D; j.ncols = 256; j.nvalid = 256; j.gain = P.norm_mix; j.coef = 0.125f; j.WT = (bf16*)(ws + WS_W0IN);
    } else if (id == 13) {
        j.W = P.a_w_in; j.ldw = 2064; j.col0 = 256; j.K = D; j.ncols = 1280; j.nvalid = 1280; j.gain = P.norm_mix; j.WT = (bf16*)(ws + WS_W0IN); j.drow0 = 256;
    } else if (id == 14) {
        j.W = P.a_w_out; j.ldw = D; j.K = D; j.ncols = D; j.nvalid = D; j.WT = (bf16*)(ws + WS_W0OUT);
    } else if (id == 15) {
        j.W = P.c_w_in; j.ldw = 1840; j.K = D; j.ncols = 1024; j.nvalid = 1024; j.gain = P.norm_mix + D; j.coef = 0.125f * LOG2E; j.WT = (bf16*)(ws + WS_W1IN);
    } else if (id == 16) {
        j.W = P.c_w_in; j.ldw = 1840; j.col0 = 1024; j.K = D; j.ncols = 1024; j.nvalid = 816; j.gain = P.norm_mix + D; j.WT = (bf16*)(ws + WS_W1IN); j.drow0 = 1024;
    } else if (id == 17) {
        j.W = P.c_w_out; j.ldw = D; j.K = D; j.ncols = D; j.nvalid = D; j.WT = (bf16*)(ws + WS_W1OUT);
    } else if (id == 18) {
        j.W = P.c_cmpk_w1; j.ldw = 256; j.K = 2048; j.ncols = 256; j.nvalid = 256; j.WT = (bf16*)(ws + WS_WC1);
    } else {
        j.W = P.c_cmpv_w1; j.ldw = 256; j.K = 2048; j.ncols = 256; j.nvalid = 256; j.WT = (bf16*)(ws + WS_WC1); j.drow0 = 256;
    }
}
constexpr int N_TJOBS = 20;

__device__ __forceinline__ void p0_prologue(const Ptrs& P, Frame& F) {
    unsigned char* ws = P.ws;
    LAS float* scr = (LAS float*)(F.lds + RING_OFF + F.wave * 16384);
    const int gw = F.vcu * NWAVES + F.wave, NGW = F.G * NWAVES;
#ifndef P0_DUP
#define P0_DUP 0
#endif
    for (int rep = 0; rep < ((P0_DUP & 1) ? 2 : 1); ++rep)
    for (int id = 0; id < N_TJOBS; ++id) {
        TJob j; get_job(P, id, j);
        const int nblk = j.ncols / 32, nitems = (j.K / 64) * nblk;
        for (int it = gw; it < nitems; it += NGW) transpose_item(j.W, j.ldw, j.col0, j.K, j.nvalid, j.gain, j.coef, j.WT, j.drow0, j.mode, scr, it, nblk, F.lane);
    }
    bf16* W0IN = (bf16*)(ws + WS_W0IN);
    for (int rep = 0; rep < ((P0_DUP & 2) ? 2 : 1); ++rep) {
    for (int it = gw; it < 256 * 16; it += NGW) {
        const int j = it >> 4, k = (it & 15) * 64 + F.lane; const float* wr = P.a_w_in + (size_t)k * 2064 + 1536; float s = 0.f;
#pragma unroll
        for (int r = 0; r < 16; ++r) s += wr[r] * P.a_gate_w2[r * 256 + j];
        W0IN[(size_t)(1536 + j) * D + k] = (bf16)f2bf(s * P.norm_mix[k]);
    }
    for (int it = gw; it < 1024 * 8; it += NGW) {
        const int k = it >> 3, g = (it >> 1) & 3, d = (it & 1) * 64 + F.lane; const float* wr = P.a_w_in + (size_t)k * 2064 + 1552 + 128 * g; const float* pw = P.a_pool_w + (size_t)g * 16384 + d;
        float s = 0.f;
#pragma unroll 8
        for (int c = 0; c < 128; ++c) s += wr[c] * pw[c * 128];
        W0IN[(size_t)(1792 + 128 * g + d) * D + k] = (bf16)f2bf(s * P.norm_mix[k] * P.a_pool_scale[128 * g + d]);
    }
    float* part = (float*)(ws + WS_MISC);
    for (int it = gw; it < 2 * 32 * 4; it += NGW) {
        const int kv = it >> 7, ch = (it >> 2) & 31, j = (it & 3) * 64 + F.lane; const float* w1 = (kv ? P.c_cmpv_w1 : P.c_cmpk_w1) + (size_t)(ch * 64) * 256 + j; const float* pe = P.c_cmp_pe + ch * 64;
        float s = 0.f;
#pragma unroll 8
        for (int k = 0; k < 64; ++k) s += pe[k] * w1[(size_t)k * 256];
        part[(kv * 32 + ch) * 256 + j] = s;
    }
    }
    bf16* hb = (bf16*)(ws + WS_HB); float* stats = (float*)(ws + WS_STATS);
    for (int rep = 0; rep < ((P0_DUP & 4) ? 2 : 1); ++rep)
    for (int m = gw; m < M; m += NGW) {
        const GAS f32x4* xr = (const GAS f32x4*)(P.x + (size_t)m * D) + F.lane; f32x4 v[4]; float s = 0.f;
#pragma unroll
        for (int j = 0; j < 4; ++j) { v[j] = xr[64 * j]; s += (v[j].x * v[j].x + v[j].y * v[j].y) + (v[j].z * v[j].z + v[j].w * v[j].w); }
        s = wave_sum(s);
        GAS unsigned long long* o8 = (GAS unsigned long long*)(hb + (size_t)m * D) + F.lane;
#pragma unroll
        for (int j = 0; j < 4; ++j) o8[64 * j] = (unsigned long long)pk2(v[j].x, v[j].y) | ((unsigned long long)pk2(v[j].z, v[j].w) << 32);
        if (F.lane < 16) stats[(size_t)m * 16 + F.lane] = (F.lane == 0) ? s : 0.f;
    }
    { v4u* pad = (v4u*)(ws + WS_BIG + (size_t)M * N1 * 2); const int gt = F.vcu * NTHR + F.tid;
      if (gt < 16 * N1 * 2 / 16) pad[gt] = (v4u){0u, 0u, 0u, 0u}; }
}

constexpr int LP = 65;
constexpr int GL_TOT = 63744;
__device__ __forceinline__ void gla_cumlog(const bf16* proj0, const float* gate_b, int row0, int h, LAS float* LA, const Frame& F) {
    const int d = F.tid & 63, ig = F.tid >> 6; const float gb = gate_b[64 * h + d]; float pre[8];
    const bf16* zp = proj0 + (size_t)(row0 + 8 * ig) * N0 + 1536 + 64 * h + d;
#pragma unroll
    for (int r = 0; r < 8; ++r) pre[r] = bf2f(zp[(size_t)r * N0]) + gb;
#pragma unroll
    for (int r = 0; r < 8; ++r) { const float zz = pre[r];
        const float e = fast_exp2(-fabsf(zz) * LOG2E); pre[r] = (fminf(zz, 0.f) - __builtin_amdgcn_logf(1.0f + e) * 0.6931471805599453f) * (1.0f / 16.0f); }
#pragma unroll
    for (int r = 1; r < 8; ++r) pre[r] += pre[r - 1];
    LAS float* TOT = (LAS float*)(F.lds + GL_TOT);
    TOT[ig * 64 + d] = pre[7];
    __syncthreads();
    float off = 0.f;
#pragma unroll
    for (int g2 = 0; g2 < 7; ++g2) off += (g2 < ig) ? TOT[g2 * 64 + d] : 0.f;
#pragma unroll
    for (int r = 0; r < 8; ++r) LA[(8 * ig + r) * LP + d] = pre[r] + off;
    __syncthreads();
}
constexpr int GL_VT = 16640, GL_XA = 35072, GL_KI = 44288, GL_ATT = 53504, GL_SS = 62720, GL_LD = 144;
__device__ __forceinline__ void gla_load_v(const bf16* proj0, int row0, int h, const Frame& F, v4u (&vv)[2]) {
    const int i = F.tid >> 3, v0 = (F.tid & 7) * 16;
#pragma unroll
    for (int q = 0; q < 2; ++q) vv[q] = *(const GAS v4u*)(proj0 + (size_t)(row0 + i) * N0 + 512 + 128 * h + v0 + 8 * q);
}
__device__ __forceinline__ void gla_write_vt(const Frame& F, const v4u (&vv)[2]) {
    const int i = F.tid >> 3, v0 = (F.tid & 7) * 16; LAS unsigned short* vt = (LAS unsigned short*)(F.lds + GL_VT) + i;
#pragma unroll
    for (int q = 0; q < 2; ++q) { const unsigned vw[4] = {vv[q].x, vv[q].y, vv[q].z, vv[q].w};
#pragma unroll
        for (int e = 0; e < 8; ++e) vt[(v0 + 8 * q + e) * (GL_LD / 2)] = (unsigned short)((e & 1) ? (vw[e >> 1] >> 16) : (vw[e >> 1] & 0xffffu)); }
}
__device__ __forceinline__ void gla_g1_unit(const Ptrs& P, Frame& F, int unit) {
    const bf16* proj0 = (const bf16*)(P.ws + WS_BIG); float* dS = (float*)(P.ws + WS_X2); float* decay = (float*)(P.ws + WS_DECAY);
    const int b = unit >> 9, h = (unit >> 7) & 3, n = unit & 127, row0 = b * T + 64 * n;
    LAS float* LA = (LAS float*)(F.lds);
    v4u vv[2]; gla_load_v(proj0, row0, h, F, vv);
    const v4u kk = *(const GAS v4u*)(proj0 + (size_t)(row0 + (F.tid >> 3)) * N0 + 256 + 64 * h + (F.tid & 7) * 8);
    gla_cumlog(proj0, P.a_gate_b, row0, h, LA, F);
    { const int i = F.tid >> 3, d0 = (F.tid & 7) * 8;
      const unsigned kw[4] = {kk.x, kk.y, kk.z, kk.w};
      LAS unsigned short* ket = (LAS unsigned short*)(F.lds + GL_XA) + i;
#pragma unroll
      for (int e = 0; e < 8; ++e) { const float kv = (e & 1) ? bfhi(kw[e >> 1]) : bflo(kw[e >> 1]); ket[(d0 + e) * (GL_LD / 2)] = (unsigned short)f2bf(kv * __expf(LA[63 * LP + d0 + e] - LA[i * LP + d0 + e])); }
      gla_write_vt(F, vv);
      if (F.tid < 64) decay[(size_t)unit * 64 + F.tid] = __expf(LA[63 * LP + F.tid]); }
    __syncthreads();
    { const int r32 = F.lane & 31, hi = F.lane >> 5, mb = F.wave >> 1, nb = F.wave & 1; f32x16 acc = f32x16{};
      const LAS unsigned char* ap = F.lds + GL_VT + (32 * mb + r32) * GL_LD + 16 * hi; const LAS unsigned char* bp = F.lds + GL_XA + (32 * nb + r32) * GL_LD + 16 * hi;
#pragma unroll
      for (int ks = 0; ks < 4; ++ks) acc = __builtin_amdgcn_mfma_f32_32x32x16_bf16(*(const LAS bf16x8*)(ap + 32 * ks), *(const LAS bf16x8*)(bp + 32 * ks), acc, 0, 0, 0);
      float* op = dS + (size_t)unit * 8192 + (size_t)(32 * mb + 4 * hi) * 64 + 32 * nb + r32;
#pragma unroll
      for (int r = 0; r < 16; ++r) op[((r & 3) + 8 * (r >> 2)) * 64] = acc[r]; }
    __syncthreads();
}
__device__ __forceinline__ void gla_g2(const Ptrs& P, Frame& F) {
    const float* dS = (const float*)(P.ws + WS_X2); const float* decay = (const float*)(P.ws + WS_DECAY); bf16* SPT = (bf16*)(P.ws + WS_SPT);
    for (int e = F.vcu * NTHR + F.tid; e < 16 * 64 * 128; e += F.G * NTHR) {
        const int bh = e >> 13, vd = e & 8191, d = e & 63; float S0 = 0.f, S1 = 0.f;
        for (int n0 = 0; n0 < 128; n0 += 16) { float ds0[16], ds1[16], dc[16];
#pragma unroll
            for (int j = 0; j < 16; ++j) { const size_t u = (size_t)bh * 128 + n0 + j; ds0[j] = dS[u * 8192 + vd]; ds1[j] = dS[u * 8192 + vd + 256]; dc[j] = decay[u * 64 + d]; }
#pragma unroll
            for (int j = 0; j < 16; ++j) { const size_t u = (size_t)bh * 128 + n0 + j; SPT[u * 8192 + vd] = (bf16)f2bf(S0); SPT[u * 8192 + vd + 256] = (bf16)f2bf(S1); S0 = dc[j] * S0 + ds0[j]; S1 = dc[j] * S1 + ds1[j]; } }
    }
}
__device__ __forceinline__ void gla_g3_unit(const Ptrs& P, Frame& F, int unit) {
    const bf16* proj0 = (const bf16*)(P.ws + WS_BIG); const bf16* SPT = (const bf16*)(P.ws + WS_SPT); bf16* ocat = (bf16*)(P.ws + WS_OCAT);
    const int b = unit >> 9, h = (unit >> 7) & 3, n = unit & 127, row0 = b * T + 64 * n;
    const int r32 = F.lane & 31, hi = F.lane >> 5, ib = F.wave >> 2, vb = F.wave & 3;
    LAS float* LA = (LAS float*)(F.lds);
    bf16x8 sf[4];
#pragma unroll
    for (int ks = 0; ks < 4; ++ks) sf[ks] = *(const GAS bf16x8*)(SPT + (size_t)unit * 8192 + (size_t)(32 * vb + r32) * 64 + 16 * ks + 8 * hi);
    v4u vv[2]; gla_load_v(proj0, row0, h, F, vv);
    const v4u qq = *(const GAS v4u*)(proj0 + (size_t)(row0 + (F.tid >> 3)) * N0 + 64 * h + (F.tid & 7) * 8);
    const v4u kk = *(const GAS v4u*)(proj0 + (size_t)(row0 + (F.tid >> 3)) * N0 + 256 + 64 * h + (F.tid & 7) * 8);
    gla_cumlog(proj0, P.a_gate_b, row0, h, LA, F);
    { const int i = F.tid >> 3, d0 = (F.tid & 7) * 8;
      const unsigned qw[4] = {qq.x, qq.y, qq.z, qq.w};
      const unsigned kw[4] = {kk.x, kk.y, kk.z, kk.w};
      float qd[8], ki[8];
#pragma unroll
      for (int e = 0; e < 8; ++e) { const float bb = LA[i * LP + d0 + e]; const float qv = (e & 1) ? bfhi(qw[e >> 1]) : bflo(qw[e >> 1]), kv = (e & 1) ? bfhi(kw[e >> 1]) : bflo(kw[e >> 1]);
          qd[e] = qv * __expf(bb); ki[e] = kv * __expf(-bb); }
      *(LAS v4u*)(F.lds + GL_XA + i * GL_LD + d0 * 2) = (v4u){pk2(qd[0], qd[1]), pk2(qd[2], qd[3]), pk2(qd[4], qd[5]), pk2(qd[6], qd[7])};
      *(LAS v4u*)(F.lds + GL_KI + i * GL_LD + d0 * 2) = (v4u){pk2(ki[0], ki[1]), pk2(ki[2], ki[3]), pk2(ki[4], ki[5]), pk2(ki[6], ki[7])};
      gla_write_vt(F, vv); }
    __syncthreads();
    f32x16 acc = f32x16{};
    const LAS unsigned char* qp = F.lds + GL_XA + (32 * ib + r32) * GL_LD + 16 * hi;
    if (F.wave == 0 || F.wave == 2 || F.wave == 3) {
        const int jb = (F.wave == 3) ? 1 : 0, ib2 = (F.wave == 0) ? 0 : 1; f32x16 at = f32x16{};
        const LAS unsigned char* kp = F.lds + GL_KI + (32 * jb + r32) * GL_LD + 16 * hi; const LAS unsigned char* qp2 = F.lds + GL_XA + (32 * ib2 + r32) * GL_LD + 16 * hi;
#pragma unroll
        for (int ks = 0; ks < 4; ++ks) at = __builtin_amdgcn_mfma_f32_32x32x16_bf16(*(const LAS bf16x8*)(kp + 32 * ks), *(const LAS bf16x8*)(qp2 + 32 * ks), at, 0, 0, 0);
        const int i = 32 * ib2 + r32;
#pragma unroll
        for (int rr = 0; rr < 4; ++rr) { const int j0 = 32 * jb + 8 * rr + 4 * hi; float a[4];
#pragma unroll
            for (int e = 0; e < 4; ++e) a[e] = (j0 + e <= i) ? at[4 * rr + e] : 0.f;
            *(LAS v2u*)(F.lds + GL_ATT + i * GL_LD + j0 * 2) = (v2u){pk2(a[0], a[1]), pk2(a[2], a[3])}; }
    }
#pragma unroll
    for (int ks = 0; ks < 4; ++ks) acc = __builtin_amdgcn_mfma_f32_32x32x16_bf16(sf[ks], *(const LAS bf16x8*)(qp + 32 * ks), acc, 0, 0, 0);
    __syncthreads();
    { const LAS unsigned char* vp = F.lds + GL_VT + (32 * vb + r32) * GL_LD + 16 * hi; const LAS unsigned char* ap = F.lds + GL_ATT + (32 * ib + r32) * GL_LD + 16 * hi;
#pragma unroll
      for (int ks = 0; ks < 4; ++ks) if (ks < 2 || ib == 1) acc = __builtin_amdgcn_mfma_f32_32x32x16_bf16(*(const LAS bf16x8*)(vp + 32 * ks), *(const LAS bf16x8*)(ap + 32 * ks), acc, 0, 0, 0); }
    { float ssq = 0.f;
#pragma unroll
      for (int r = 0; r < 16; ++r) ssq += acc[r] * acc[r];
      ssq += __shfl_xor(ssq, 32);
      LAS float* SS = (LAS float*)(F.lds + GL_SS); const int i = 32 * ib + r32;
      if (hi == 0) SS[vb * 64 + i] = ssq;
      __syncthreads();
      const float tot = (SS[i] + SS[64 + i]) + (SS[128 + i] + SS[192 + i]); const float rs = __builtin_amdgcn_rsqf(tot * (1.0f / 128.0f) + EPS);
      const bf16* gp = proj0 + (size_t)(row0 + i) * N0 + 1024 + 128 * h + 32 * vb + 4 * hi; bf16* op = ocat + (size_t)(row0 + i) * D + 128 * h + 32 * vb + 4 * hi; const float* gn = P.a_gla_norm + 32 * vb + 4 * hi;
#pragma unroll
      for (int rr = 0; rr < 4; ++rr) { const v2u gw = *(const GAS v2u*)(gp + 8 * rr); const f32x4 nn = *(const f32x4*)(gn + 8 * rr);
          const float o0 = acc[4 * rr] * rs * nn[0] * siluf_(bflo(gw.x)), o1 = acc[4 * rr + 1] * rs * nn[1] * siluf_(bfhi(gw.x)), o2 = acc[4 * rr + 2] * rs * nn[2] * siluf_(bflo(gw.y)), o3 = acc[4 * rr + 3] * rs * nn[3] * siluf_(bfhi(gw.y));
          *(GAS v2u*)(op + 8 * rr) = (v2u){pk2(o0, o1), pk2(o2, o3)}; } }
    __syncthreads();
}
__device__ __forceinline__ void pool_phase(const Ptrs& P, Frame& F, int pt, int npt) {
    const bf16* proj0 = (const bf16*)(P.ws + WS_BIG); bf16* ocat = (bf16*)(P.ws + WS_OCAT);
    for (int it = F.vcu * npt + pt; it < (M / 16) * 64; it += F.G * npt) {
        const int seg = it >> 6, ch = it & 63, r0 = seg * 16, t0 = r0 & (T - 1), w = 2 << (ch >> 4);
        const bf16* src = proj0 + (size_t)r0 * N0 + 1792 + ch * 8; bf16* dst = ocat + (size_t)r0 * D + 512 + ch * 8;
        float sum[8];
#pragma unroll
        for (int e = 0; e < 8; ++e) sum[e] = 0.f;
        for (int q = 1; q < w; ++q) if (t0 - q >= 0) { const v4u pv = *(const GAS v4u*)(src - (size_t)q * N0); const unsigned pw[4] = {pv.x, pv.y, pv.z, pv.w};
#pragma unroll
            for (int e = 0; e < 8; ++e) sum[e] += (e & 1) ? bfhi(pw[e >> 1]) : bflo(pw[e >> 1]); }
#pragma unroll 4
        for (int i = 0; i < 16; ++i) { const int t = t0 + i; const int cnt = (t + 1 < w) ? t + 1 : w;
            const v4u pv = *(const GAS v4u*)(src + (size_t)i * N0); const unsigned pw[4] = {pv.x, pv.y, pv.z, pv.w}; float x[8];
#pragma unroll
            for (int e = 0; e < 8; ++e) { x[e] = (e & 1) ? bfhi(pw[e >> 1]) : bflo(pw[e >> 1]); sum[e] += x[e]; }
            const float inv = 1.0f / (float)cnt; v4u o;
            o.x = pk2(sum[0] * inv - x[0], sum[1] * inv - x[1]); o.y = pk2(sum[2] * inv - x[2], sum[3] * inv - x[3]);
            o.z = pk2(sum[4] * inv - x[4], sum[5] * inv - x[5]); o.w = pk2(sum[6] * inv - x[6], sum[7] * inv - x[7]);
            *(GAS v4u*)(dst + (size_t)i * D) = o;
            if (t - w + 1 >= 0) { const v4u qv = *(const GAS v4u*)(src + (size_t)(i - w + 1) * N0); const unsigned qw[4] = {qv.x, qv.y, qv.z, qv.w};
#pragma unroll
                for (int e = 0; e < 8; ++e) sum[e] -= (e & 1) ? bfhi(qw[e >> 1]) : bflo(qw[e >> 1]); } }
    }
}
__device__ __forceinline__ void cmp2_phase(const Ptrs& P, Frame& F) {
    const float* part = (const float*)(P.ws + WS_OCAT); const float* bias = (const float*)(P.ws + WS_MISC + 128 * 1024); bf16* kc = (bf16*)(P.ws + WS_X2 + 4 * MiB);
    LAS float* hs = (LAS float*)(F.lds) + F.wave * 256; const int gw = F.vcu * NWAVES + F.wave, NGW = F.G * NWAVES;
    for (int row = gw; row < 8192; row += NGW) {
        const int kv = row >> 12; f32x4 a = *(const f32x4*)(bias + kv * 256 + 4 * F.lane);
#pragma unroll
        for (int sl = 0; sl < 8; ++sl) a += *(const GAS f32x4*)(part + ((size_t)sl * 8192 + row) * 256 + 4 * F.lane);
        *(LAS f32x4*)(hs + 4 * F.lane) = (f32x4){pg8::gelu_tanh_(a[0]), pg8::gelu_tanh_(a[1]), pg8::gelu_tanh_(a[2]), pg8::gelu_tanh_(a[3])};
        LDS_WAIT(); asm volatile("" ::: "memory");
        const float* w2 = (kv ? P.c_cmpv_w2 : P.c_cmpk_w2) + F.lane; float s = 0.f;
#pragma unroll 4
        for (int j = 0; j < 256; j += 4) { const f32x4 hv = *(const LAS f32x4*)(hs + j); s += hv[0] * w2[(j + 0) * 64] + hv[1] * w2[(j + 1) * 64] + hv[2] * w2[(j + 2) * 64] + hv[3] * w2[(j + 3) * 64]; }
        if ((row & 511) == 511) s = 0.f;
        kc[(size_t)row * 64 + F.lane] = (bf16)f2bf(s);
        LDS_WAIT(); asm volatile("" ::: "memory");
    }
}
__device__ __forceinline__ void final_norm_phase(const Ptrs& P, Frame& F) {
    const float* stats = (const float*)(P.ws + WS_STATS); const bf16* hb = (const bf16*)(P.ws + WS_HB); const int gw = F.vcu * NWAVES + F.wave, NGW = F.G * NWAVES;
    for (int m = gw; m < M; m += NGW) {
        float s = (F.lane < 16) ? stats[(size_t)m * 16 + F.lane] : 0.f; s = wave_sum(s); const float rs = __builtin_amdgcn_rsqf(s * (1.0f / 1024.0f) + EPS);
        const GAS v4u* hr = (const GAS v4u*)(hb + (size_t)m * D) + 2 * F.lane; GAS f32x4* xr = (GAS f32x4*)(P.out + (size_t)m * D) + 4 * F.lane; const GAS f32x4* gn = (const GAS f32x4*)P.final_norm + 4 * F.lane;
#pragma unroll
        for (int j = 0; j < 2; ++j) { const v4u h = hr[j];
            xr[2 * j] = (f32x4){bflo(h.x), bfhi(h.x), bflo(h.y), bfhi(h.y)} * rs * gn[2 * j]; xr[2 * j + 1] = (f32x4){bflo(h.z), bfhi(h.z), bflo(h.w), bfhi(h.w)} * rs * gn[2 * j + 1]; }
    }
}

namespace nsa {
typedef float f32x2 __attribute__((ext_vector_type(2)));
typedef short v4i16_t __attribute__((ext_vector_type(4)));
typedef float f32x4_t __attribute__((ext_vector_type(4)));
constexpr int NBUF = 2, KB_OFF = 0, KB_SZ = 8192, VB_OFF = NBUF * KB_SZ, V_ROW = 192, VB_SZ = 64 * V_ROW;
constexpr int IMP_OFF = VB_OFF + NBUF * VB_SZ;
constexpr int IMP_LD = 132;
constexpr int IMPT_OFF = IMP_OFF + 32 * IMP_LD * 4;
constexpr int IMPT_LD = 17;
constexpr int SELM_OFF = IMPT_OFF + 8 * 32 * IMPT_LD * 4;
constexpr int UL_OFF = SELM_OFF + 512 + 64;
constexpr int KMX_OFF = UL_OFF + 528;
constexpr int OA_OFF = UL_OFF + 576;
static_assert(OA_OFF + 32 * 512 * 4 <= LDSCTL_OFF, "NSA LDS map");
constexpr float NEGV = -1e30f;

#define NSA_DPP(x, CTRL) __builtin_bit_cast(float, __builtin_amdgcn_mov_dpp(__builtin_bit_cast(int, (x)), (CTRL), 0xf, 0xf, true))
__device__ __forceinline__ float sum8(float v) { v += NSA_DPP(v, 0xB1); v += NSA_DPP(v, 0x4E); v += NSA_DPP(v, 0x141); return v; }
__device__ __forceinline__ float ksq8(const v4u& x) {
    const float a0 = bflo(x.x), a1 = bfhi(x.x), a2 = bflo(x.y), a3 = bfhi(x.y), a4 = bflo(x.z), a5 = bfhi(x.z), a6 = bflo(x.w), a7 = bfhi(x.w);
    return fmaf(a0, a0, fmaf(a1, a1, fmaf(a2, a2, a3 * a3))) + fmaf(a4, a4, fmaf(a5, a5, fmaf(a6, a6, a7 * a7))); }
__device__ __forceinline__ float max3(float a, float b, float c) { float r; asm("v_max3_f32 %0, %1, %2, %3" : "=v"(r) : "v"(a), "v"(b), "v"(c)); return r; }
__device__ __forceinline__ float wave_max(float v) {
    v = fmaxf(v, NSA_DPP(v, 0xB1)); v = fmaxf(v, NSA_DPP(v, 0x4E)); v = fmaxf(v, NSA_DPP(v, 0x141)); v = fmaxf(v, NSA_DPP(v, 0x128));
    const float a = __builtin_bit_cast(float, __builtin_amdgcn_readlane(__builtin_bit_cast(int, v), 0)), b = __builtin_bit_cast(float, __builtin_amdgcn_readlane(__builtin_bit_cast(int, v), 16));
    const float c = __builtin_bit_cast(float, __builtin_amdgcn_readlane(__builtin_bit_cast(int, v), 32)), d = __builtin_bit_cast(float, __builtin_amdgcn_readlane(__builtin_bit_cast(int, v), 48));
    return fmaxf(fmaxf(a, b), fmaxf(c, d));
}
__device__ __forceinline__ void swap32(float v, float& a, float& b) {
    a = v; b = v;
    asm volatile("s_nop 1\n\tv_permlane32_swap_b32 %0, %1\n\ts_nop 1" : "+v"(a), "+v"(b));
}
__device__ __forceinline__ float partner(float v) { float a, b; swap32(v, a, b); return (threadIdx.x & 32) ? a : b; }
__device__ __forceinline__ float both_max(float v) { float a, b; swap32(v, a, b); return fmaxf(a, b); }
__device__ __forceinline__ float both_sum(float v) { float a, b; swap32(v, a, b); return a + b; }

#if DIAG
#define NSA_FLAG(cond, bitv) do { if (cond) (void)__hip_atomic_fetch_or((unsigned*)(P.ws + WS_CTL) + 64, (bitv), __ATOMIC_RELAXED, __HIP_MEMORY_SCOPE_AGENT); } while (0)
__device__ __forceinline__ bool nonfin(float v) { return !(fabsf(v) < 3e38f); }
__device__ __forceinline__ bool nonfin16(const f32x16& v) { bool b = false;
#pragma unroll
    for (int r = 0; r < 16; ++r) b = b || nonfin(v[r]); return b; }
__device__ __forceinline__ bool bfbad(unsigned w) { return ((w & 0x7f80u) == 0x7f80u) || ((w & 0x7f800000u) == 0x7f800000u); }
#else
#define NSA_FLAG(cond, bitv) do { } while (0)
#endif
__device__ __forceinline__ void nsa_unit(const Ptrs& P, Frame& F, int bg, int tt, int nbg, int ntt, bool first, int& cbio) {
    const bf16* proj1 = (const bf16*)(P.ws + WS_BIG);
    const bf16* kcmp = (const bf16*)(P.ws + WS_X2 + 4 * MiB);
    const bf16* vcmp = kcmp + 4096 * 64;
    bf16* ocat = (bf16*)(P.ws + WS_OCAT);
    LAS unsigned char* L = F.lds;
    const int b = bg >> 1, g = bg & 1, lane = F.lane, r32 = lane & 31, hi = lane >> 5, w = F.wave, tid = F.tid;
    const int hh = (w < 4) ? w : 11 - w;
    const int t0 = tt * 32, t = t0 + r32, hq = g * 8 + hh;
    const size_t row = (size_t)b * T + t;
    const float sl2 = exp2f(-0.5f * (float)(hh * 2 + g + 1)) * LOG2E;
    bf16x8 qf[4];
#pragma unroll
    for (int d0 = 0; d0 < 4; ++d0) qf[d0] = *(const GAS bf16x8*)(proj1 + row * N1 + hq * 64 + d0 * 16 + hi * 8);
    float qn2 = 0.f;
#pragma unroll
    for (int d0 = 0; d0 < 4; ++d0) { const v4u x = __builtin_bit_cast(v4u, qf[d0]); qn2 += ksq8(x); }
    qn2 = both_sum(qn2) * 1.0001f;
#define NSA_GATE(k_) ({ int go_ = (int)(row * N1) + 1792 + hq * 3 + (k_); asm volatile("" : "+v"(go_)); sigmoidf_(bf2f(proj1[go_])); })
    LAS float* IMP = (LAS float*)(L + IMP_OFF); LAS float* IMPT = (LAS float*)(L + IMPT_OFF);
    for (int i = tid; i < 32 * IMP_LD; i += NTHR) IMP[i] = 0.f;
    const int vtoff = (4 * hi + ((lane & 15) >> 2)) * V_ROW + (16 * ((lane >> 4) & 1) + 4 * (lane & 3)) * 2;
    const int srow = (tid >> 3) & 31, sch = tid & 7;
    v4u kreg, vreg, kreg2, vreg2;
#define NSA_LOAD(Kg, Vg, pitch) do { if (w < 4) { kreg = *(const GAS v4u*)((Kg) + (size_t)srow * (pitch) + sch * 8); vreg = *(const GAS v4u*)((Vg) + (size_t)srow * (pitch) + sch * 8); \
        kreg2 = *(const GAS v4u*)((Kg) + (size_t)(srow + 32) * (pitch) + sch * 8); vreg2 = *(const GAS v4u*)((Vg) + (size_t)(srow + 32) * (pitch) + sch * 8); } } while (0)
#define NSA_WRITE(buf) do { if (w < 4) { LAS unsigned char* kw_ = L + (KB_OFF + srow * 128 + ((sch ^ (srow & 7)) << 4)) + (buf) * KB_SZ; LAS unsigned char* vw_ = L + (VB_OFF + srow * V_ROW + sch * 16) + (buf) * VB_SZ; \
        *(LAS v4u*)kw_ = kreg; *(LAS v4u*)vw_ = vreg; *(LAS v4u*)(kw_ + 32 * 128) = kreg2; *(LAS v4u*)(vw_ + 32 * V_ROW) = vreg2; \
        float ka_ = ksq8(kreg), kb_ = ksq8(kreg2); ka_ = wave_max(fmaxf(sum8(ka_), sum8(kb_))); if (lane == 0) ((LAS float*)(L + KMX_OFF))[(buf) * 4 + w] = ka_; } } while (0)
#define NSA_SB() __builtin_amdgcn_sched_barrier(0)
#define NSA_KLD(x0_, x1_, d0_) do { const int off_ = (((2 * (d0_) + hi) ^ (r32 & 7)) << 4); x0_ = *(const LAS bf16x8*)(kb_ + off_); x1_ = *(const LAS bf16x8*)(kb_ + 32 * 128 + off_); } while (0)
#define NSA_QK(buf, slm_, cb_) do { const LAS unsigned char* kb_ = L + KB_OFF + (buf) * KB_SZ + r32 * 128; bf16x8 ka0_, ka1_, kb0_, kb1_; \
        NSA_KLD(ka0_, ka1_, 0); NSA_KLD(kb0_, kb1_, 1); NSA_SB(); \
        _Pragma("unroll") for (int r = 0; r < 16; ++r) { const int c_ = (r & 3) + 8 * (r >> 2); p0[r] = fmaf((slm_), (float)c_, (cb_)); p1[r] = fmaf((slm_), (float)(c_ + 32), (cb_)); } \
        NSA_SB(); \
        p0 = __builtin_amdgcn_mfma_f32_32x32x16_bf16(ka0_, qf[0], p0, 0, 0, 0); p1 = __builtin_amdgcn_mfma_f32_32x32x16_bf16(ka1_, qf[0], p1, 0, 0, 0); NSA_KLD(ka0_, ka1_, 2); NSA_SB(); \
        p0 = __builtin_amdgcn_mfma_f32_32x32x16_bf16(kb0_, qf[1], p0, 0, 0, 0); p1 = __builtin_amdgcn_mfma_f32_32x32x16_bf16(kb1_, qf[1], p1, 0, 0, 0); NSA_KLD(kb0_, kb1_, 3); NSA_SB(); \
        p0 = __builtin_amdgcn_mfma_f32_32x32x16_bf16(ka0_, qf[2], p0, 0, 0, 0); p1 = __builtin_amdgcn_mfma_f32_32x32x16_bf16(ka1_, qf[2], p1, 0, 0, 0); NSA_SB(); \
        p0 = __builtin_amdgcn_mfma_f32_32x32x16_bf16(kb0_, qf[3], p0, 0, 0, 0); p1 = __builtin_amdgcn_mfma_f32_32x32x16_bf16(kb1_, qf[3], p1, 0, 0, 0); } while (0)
#define NSA_VTR(p_) __builtin_bit_cast(v2u, __builtin_amdgcn_ds_read_tr16_b64_v4i16((LAS v4i16_t*)(p_)))
#define NSA_VLD(lo_, hi_, k_) do { const LAS unsigned char* vp_ = vb_ + (16 * ((k_) >> 1)) * V_ROW + ((k_) & 1) * 64; lo_ = NSA_VTR(vp_); hi_ = NSA_VTR(vp_ + 8 * V_ROW); } while (0)
#define NSA_PV_PRE(buf) const LAS unsigned char* vb_ = L + VB_OFF + (buf) * VB_SZ + vtoff; v2u vl0_, vh0_, vl1_, vh1_; NSA_VLD(vl0_, vh0_, 0); NSA_VLD(vl1_, vh1_, 1); NSA_SB()
#define NSA_PV_MAIN() do { \
        _Pragma("unroll") for (int g_ = 0; g_ < 4; ++g_) { v4u pw_; \
            if (g_ < 2) { pw_.x = pg8::cvt_pk_bf16(p0[8 * (g_ & 1) + 0], p0[8 * (g_ & 1) + 1]); pw_.y = pg8::cvt_pk_bf16(p0[8 * (g_ & 1) + 2], p0[8 * (g_ & 1) + 3]); pw_.z = pg8::cvt_pk_bf16(p0[8 * (g_ & 1) + 4], p0[8 * (g_ & 1) + 5]); pw_.w = pg8::cvt_pk_bf16(p0[8 * (g_ & 1) + 6], p0[8 * (g_ & 1) + 7]); } \
            else { pw_.x = pg8::cvt_pk_bf16(p1[8 * (g_ & 1) + 0], p1[8 * (g_ & 1) + 1]); pw_.y = pg8::cvt_pk_bf16(p1[8 * (g_ & 1) + 2], p1[8 * (g_ & 1) + 3]); pw_.z = pg8::cvt_pk_bf16(p1[8 * (g_ & 1) + 4], p1[8 * (g_ & 1) + 5]); pw_.w = pg8::cvt_pk_bf16(p1[8 * (g_ & 1) + 6], p1[8 * (g_ & 1) + 7]); } \
            const bf16x8 pf_ = __builtin_bit_cast(bf16x8, pw_); \
            o0 = __builtin_amdgcn_mfma_f32_32x32x16_bf16(__builtin_bit_cast(bf16x8, (v4u){vl0_.x, vl0_.y, vh0_.x, vh0_.y}), pf_, o0, 0, 0, 0); if (g_ < 3) NSA_VLD(vl0_, vh0_, 2 * g_ + 2); NSA_SB(); \
            o1 = __builtin_amdgcn_mfma_f32_32x32x16_bf16(__builtin_bit_cast(bf16x8, (v4u){vl1_.x, vl1_.y, vh1_.x, vh1_.y}), pf_, o1, 0, 0, 0); if (g_ < 3) NSA_VLD(vl1_, vh1_, 2 * g_ + 3); NSA_SB(); } } while (0)
#define NSA_MASK(lim_, lo_) do { \
        _Pragma("unroll") for (int r = 0; r < 16; ++r) { const int c_ = (r & 3) + 8 * (r >> 2); \
            p0[r] = (c_ <= (lim_) && c_ > (lo_)) ? p0[r] : NEGV; p1[r] = (c_ + 32 <= (lim_) && c_ + 32 > (lo_)) ? p1[r] : NEGV; } } while (0)
#define NSA_ROWMAX(mx_) do { float a_ = max3(p0[0], p1[0], p0[1]), b_ = max3(p0[8], p1[8], p0[9]); a_ = max3(a_, p1[1], p0[2]); b_ = max3(b_, p1[9], p0[10]); \
        a_ = max3(a_, p1[2], p0[3]); b_ = max3(b_, p1[10], p0[11]); a_ = max3(a_, p1[3], p0[4]); b_ = max3(b_, p1[11], p0[12]); a_ = max3(a_, p1[4], p0[5]); b_ = max3(b_, p1[12], p0[13]); \
        a_ = max3(a_, p1[5], p0[6]); b_ = max3(b_, p1[13], p0[14]); a_ = max3(a_, p1[6], p0[7]); b_ = max3(b_, p1[14], p0[15]); a_ = max3(a_, p1[7], p1[15]); mx_ = both_max(max3(a_, b_, b_)); } while (0)
#define EREF() ((m_run > -1e29f) ? m_run : 0.f)
#define NSA_ONLINE(WITH_O, mx_) do { const bool val_ = m_run > -1e29f; const bool sh_ = val_ ? ((mx_) > 0.f) : ((mx_) > -1e29f); \
        if (__any(sh_)) { const float dl_ = sh_ ? (mx_) : 0.f; const float alpha_ = val_ ? fast_exp2(-dl_) : 0.f; l_run *= alpha_; m_run = sh_ ? ((val_ ? m_run : 0.f) + dl_) : m_run; \
            _Pragma("unroll") for (int r = 0; r < 16; ++r) { p0[r] -= dl_; p1[r] -= dl_; } \
            if (WITH_O) { _Pragma("unroll") for (int r = 0; r < 16; ++r) { o0[r] *= alpha_; o1[r] *= alpha_; } } } \
        f32x2 ls2_ = (f32x2){0.f, 0.f}; _Pragma("unroll") for (int r = 0; r < 16; r += 2) { p0[r] = fast_exp2(p0[r]); p0[r + 1] = fast_exp2(p0[r + 1]); p1[r] = fast_exp2(p1[r]); p1[r + 1] = fast_exp2(p1[r + 1]); \
            ls2_ += (f32x2){p0[r], p0[r + 1]}; ls2_ += (f32x2){p1[r], p1[r + 1]}; } \
        l_run += ls2_[0] + ls2_[1]; } while (0)
#define NSA_SKIPPABLE(mx_) __all((m_run > -1e29f) ? ((mx_) <= -SKIP) : ((mx_) < -1e29f))
#define NXT(x_) (((x_) == NBUF - 1) ? 0 : (x_) + 1)
#define NSA_BOUNDSKIP(buf, slm_, cb_, nov_) ({ const f32x4_t kx_ = *(const LAS f32x4_t*)(L + KMX_OFF + (buf) * 16); const float km_ = fmaxf(fmaxf(kx_[0], kx_[1]), fmaxf(kx_[2], kx_[3])); \
        const float ub_ = __builtin_amdgcn_sqrtf(qn2 * km_) + fmaf((slm_), 63.f, (cb_)) + 0.01f; __all((m_run > -1e29f) ? (ub_ <= -SKIP) : (nov_)); })
    constexpr float SKIP = 30.f;
    f32x16 p0, p1, o0, o1;
    LAS float* OA = (LAS float*)(L + OA_OFF) + tid;
    float m_run, l_run;

    const int nkt = (t0 >> 10) + 1;
    const int cmaxv = (t - 31) >> 4;
    const bf16* kcb = kcmp + (size_t)bg * 512 * 64; const bf16* vcb = vcmp + (size_t)bg * 512 * 64;
    const bf16* ksb = proj1 + (size_t)b * T * N1 + 1280 + g * 64; const bf16* vsb = proj1 + (size_t)b * T * N1 + 1408 + g * 64;
    const bf16* kwb = proj1 + (size_t)b * T * N1 + 1536 + g * 64; const bf16* vwb = proj1 + (size_t)b * T * N1 + 1664 + g * 64;
    const int jhi = t0 >> 6;
    const int cfull = (t0 - 31) >> 4;
    const float slmc = 16.f * sl2;
    int cb = cbio;
    if (first) { cb = 0; NSA_LOAD(kcb + (size_t)(nkt - 1) * 4096, vcb + (size_t)(nkt - 1) * 4096, 64); NSA_WRITE(0); __syncthreads(); }
    m_run = NEGV; l_run = 0.f;
    for (int i = nkt - 1; i >= 0; --i) {
        const int nx = (i > 0) ? i - 1 : nkt - 1;
        NSA_LOAD(kcb + (size_t)nx * 4096, vcb + (size_t)nx * 4096, 64);
        { const float cbv = sl2 * (float)(1024 * i + 31 - t) + slmc * (float)(4 * hi) - EREF();
          if (!NSA_BOUNDSKIP(cb, slmc, cbv, cmaxv < 64 * i)) {
            NSA_QK(cb, slmc, cbv);
            if (64 * i + 63 > cfull) { const int lim = cmaxv - 64 * i - 4 * hi; NSA_MASK(lim, -100000); }
            float mx; NSA_ROWMAX(mx); if (!NSA_SKIPPABLE(mx)) NSA_ONLINE(false, mx); } }
        NSA_WRITE(NXT(cb));
        __syncthreads(); cb = NXT(cb);
    }
    const float ltot = both_sum(l_run); const float adjc = (m_run > -1e29f) ? (-m_run - __builtin_amdgcn_logf(ltot)) : NEGV;
    o0 = f32x16{}; o1 = f32x16{};
    for (int i = nkt - 1; i >= 0; --i) {
        if (i > 0) NSA_LOAD(kcb + (size_t)(i - 1) * 4096, vcb + (size_t)(i - 1) * 4096, 64);
        else NSA_LOAD(ksb + (size_t)jhi * 64 * N1, vsb + (size_t)jhi * 64 * N1, N1);
        const float cbv = sl2 * (float)(1024 * i + 31 - t) + slmc * (float)(4 * hi) + adjc;
        bool skp; { const f32x4_t kx_ = *(const LAS f32x4_t*)(L + KMX_OFF + cb * 16); const float km_ = fmaxf(fmaxf(kx_[0], kx_[1]), fmaxf(kx_[2], kx_[3]));
                    skp = __all(__builtin_amdgcn_sqrtf(qn2 * km_) + fmaf(slmc, 63.f, cbv) + 0.01f <= -SKIP); }
        if (!skp) {
            NSA_QK(cb, slmc, cbv);
            if (64 * i + 63 > cfull) { const int lim = cmaxv - 64 * i - 4 * hi; NSA_MASK(lim, -100000); }
            float mxn; NSA_ROWMAX(mxn); skp = __all(mxn <= -SKIP); }
        LAS float* it_ = IMPT + (w * 32 + r32) * IMPT_LD + hi;
        if (skp) {
#pragma unroll
            for (int q = 0; q < 8; ++q) it_[2 * q] = 0.f;
            if (hi == 0) it_[16] = 0.f;
        } else {
          NSA_PV_PRE(cb);
#pragma unroll
          for (int r = 0; r < 16; ++r) { p0[r] = fast_exp2(p0[r]); p1[r] = fast_exp2(p1[r]); }
          float mainv[2][4], cr[2][4];
#pragma unroll
          for (int rr = 0; rr < 4; ++rr) { mainv[0][rr] = p0[4 * rr] + p0[4 * rr + 1] + p0[4 * rr + 2] + 0.5f * p0[4 * rr + 3]; cr[0][rr] = partner(0.5f * p0[4 * rr + 3]);
                                           mainv[1][rr] = p1[4 * rr] + p1[4 * rr + 1] + p1[4 * rr + 2] + 0.5f * p1[4 * rr + 3]; cr[1][rr] = partner(0.5f * p1[4 * rr + 3]); }
#pragma unroll
          for (int pp = 0; pp < 2; ++pp)
#pragma unroll
              for (int rr = 0; rr < 4; ++rr) { const float prev = (rr > 0) ? cr[pp][rr - 1] : (pp ? cr[0][3] : 0.f); mainv[pp][rr] += hi ? cr[pp][rr] : prev; }
#pragma unroll
          for (int pp = 0; pp < 2; ++pp)
#pragma unroll
              for (int rr = 0; rr < 4; ++rr) it_[8 * pp + 2 * rr] = mainv[pp][rr];
          if (hi == 0) it_[16] = cr[1][3];
          NSA_PV_MAIN();
        }
        NSA_WRITE(NXT(cb));
        __syncthreads(); cb = NXT(cb);
        { const int tok_ = tid >> 4, sl_ = tid & 15; float s_ = 0.f;
#pragma unroll
          for (int hd = 0; hd < 8; ++hd) s_ += IMPT[(hd * 32 + tok_) * IMPT_LD + sl_];
          IMP[tok_ * IMP_LD + 16 * i + sl_] += s_;
          if (tid < 32) { float c_ = 0.f;
#pragma unroll
              for (int hd = 0; hd < 8; ++hd) c_ += IMPT[(hd * 32 + tid) * IMPT_LD + 16];
              IMP[tid * IMP_LD + 16 * (i + 1)] += c_; } }
        __syncthreads();
    }
    { const float gate0 = NSA_GATE(0);
#pragma unroll
      for (int r = 0; r < 16; ++r) { OA[r * 512] = gate0 * o0[r]; OA[(16 + r) * 512] = gate0 * o1[r]; } }

    {
        const int tokq = lane >> 4, l16 = lane & 15, tokn = w * 4 + tokq, tq = t0 + tokn, cur = tq >> 6;
        unsigned m0 = 0u, m1 = 0u, m2 = 0u, m3 = 0u;
        if ((((t0 + 31) >> 6) + 1) <= 16) {
            const unsigned long long ml = (1ull << (cur + 1)) - 1ull; m0 = (unsigned)ml; m1 = (unsigned)(ml >> 32);
        } else {
            float v[8]; unsigned selb = 0u;
#pragma unroll
            for (int k = 0; k < 8; ++k) { const int blk = l16 + 16 * k; const float x = IMP[tokn * IMP_LD + blk];
                v[k] = (blk > cur) ? -1.f : ((blk == 0 || blk == cur || blk == cur - 1) ? 1e4f : x); }
            for (int it = 0; it < 16; ++it) {
                float lm = fmaxf(fmaxf(fmaxf(v[0], v[1]), fmaxf(v[2], v[3])), fmaxf(fmaxf(v[4], v[5]), fmaxf(v[6], v[7])));
                lm = fmaxf(lm, NSA_DPP(lm, 0xB1)); lm = fmaxf(lm, NSA_DPP(lm, 0x4E)); lm = fmaxf(lm, NSA_DPP(lm, 0x141)); lm = fmaxf(lm, NSA_DPP(lm, 0x128));
                int cand = 255;
#pragma unroll
                for (int k = 7; k >= 0; --k) cand = (v[k] == lm) ? (l16 + 16 * k) : cand;
#define NSA_DPPI(x, CTRL) __builtin_amdgcn_mov_dpp((x), (CTRL), 0xf, 0xf, true)
                cand = min(cand, NSA_DPPI(cand, 0xB1)); cand = min(cand, NSA_DPPI(cand, 0x4E)); cand = min(cand, NSA_DPPI(cand, 0x141)); cand = min(cand, NSA_DPPI(cand, 0x128));
#pragma unroll
                for (int k = 0; k < 8; ++k) { const bool hit = (l16 + 16 * k) == cand; v[k] = hit ? -2.f : v[k]; selb |= hit ? (1u << k) : 0u; }
            }
            m0 = (((selb >> 0) & 1u) << l16) | (((selb >> 1) & 1u) << (l16 + 16)); m1 = (((selb >> 2) & 1u) << l16) | (((selb >> 3) & 1u) << (l16 + 16));
            m2 = (((selb >> 4) & 1u) << l16) | (((selb >> 5) & 1u) << (l16 + 16)); m3 = (((selb >> 6) & 1u) << l16) | (((selb >> 7) & 1u) << (l16 + 16));
#define NSA_ORROW(x) do { x |= (unsigned)NSA_DPPI((int)x, 0xB1); x |= (unsigned)NSA_DPPI((int)x, 0x4E); x |= (unsigned)NSA_DPPI((int)x, 0x141); x |= (unsigned)NSA_DPPI((int)x, 0x128); } while (0)
            NSA_ORROW(m0); NSA_ORROW(m1); NSA_ORROW(m2); NSA_ORROW(m3);
#undef NSA_ORROW
#undef NSA_DPPI
            const unsigned long long vlo = (cur >= 63) ? ~0ull : ((1ull << (cur + 1)) - 1ull), vhi = (cur >= 64) ? ((cur >= 127) ? ~0ull : ((1ull << (cur - 63)) - 1ull)) : 0ull;
            m0 &= (unsigned)vlo; m1 &= (unsigned)(vlo >> 32); m2 &= (unsigned)vhi; m3 &= (unsigned)(vhi >> 32);
        }
        if (l16 == 0) *(LAS v4u*)(L + SELM_OFF + tokn * 16) = (v4u){m0, m1, m2, m3};
    }
    __syncthreads();
    if (w == 0) {
        unsigned long long ulo = 0ull, uhi = 0ull, alo = ~0ull, ahi = ~0ull;
        for (int q = 0; q < 32; ++q) { const v4u sm = *(const LAS v4u*)(L + SELM_OFF + q * 16); const unsigned long long a = ((unsigned long long)sm.y << 32) | sm.x, c = ((unsigned long long)sm.w << 32) | sm.z;
            ulo |= a; uhi |= c; alo &= a; ahi &= c; }
        LAS int* UL = (LAS int*)(L + UL_OFF); const int nlo = __builtin_popcountll(ulo);
        if ((ulo >> lane) & 1ull) UL[1 + __builtin_amdgcn_mbcnt_hi((unsigned)(ulo >> 32), __builtin_amdgcn_mbcnt_lo((unsigned)ulo, 0u))] = lane;
        if ((uhi >> lane) & 1ull) UL[1 + nlo + __builtin_amdgcn_mbcnt_hi((unsigned)(uhi >> 32), __builtin_amdgcn_mbcnt_lo((unsigned)uhi, 0u))] = 64 + lane;
        if (lane == 0) { UL[0] = nlo + __builtin_popcountll(uhi); *(LAS v4u*)(L + SELM_OFF + 32 * 16) = (v4u){(unsigned)alo, (unsigned)(alo >> 32), (unsigned)ahi, (unsigned)(ahi >> 32)}; }
    }
    __syncthreads();

    {
        const LAS unsigned* SELW = (const LAS unsigned*)(L + SELM_OFF);
        const LAS int* UL = (const LAS int*)(L + UL_OFF); const int nsel = __builtin_amdgcn_readfirstlane(UL[0]);
        m_run = NEGV; l_run = 0.f; o0 = f32x16{}; o1 = f32x16{};
        int jn = jhi;
        for (int i = 0; i < nsel; ++i) {
            const int j = jn;
            if (i + 1 < nsel) { jn = __builtin_amdgcn_readfirstlane(UL[nsel - 1 - i]); NSA_LOAD(ksb + (size_t)jn * 64 * N1, vsb + (size_t)jn * 64 * N1, N1); }
            else NSA_LOAD(kwb + (size_t)jhi * 64 * N1, vwb + (size_t)jhi * 64 * N1, N1);
            { const bool mysel = ((SELW[r32 * 4 + (j >> 5)] >> (j & 31)) & 1u) != 0u; const float cbv = mysel ? (sl2 * (float)(64 * j - t + 4 * hi) - EREF()) : NEGV;
              if (!NSA_BOUNDSKIP(cb, sl2, cbv, !mysel)) {
                NSA_QK(cb, sl2, cbv);
                if (j == jhi) { const int lim = t - 64 * j - 4 * hi; NSA_MASK(lim, -100000); }
                float mx; NSA_ROWMAX(mx);
                if (!NSA_SKIPPABLE(mx)) { NSA_PV_PRE(cb); NSA_ONLINE(true, mx); NSA_PV_MAIN(); } } }
            NSA_WRITE(NXT(cb));
            __syncthreads(); cb = NXT(cb);
        }
        const float il = NSA_GATE(1) * fast_rcp(both_sum(l_run));
#pragma unroll
        for (int r = 0; r < 16; ++r) { OA[r * 512] += il * o0[r]; OA[(16 + r) * 512] += il * o1[r]; }
    }
    {
        const int jlo = (t0 >= 511) ? ((t0 - 511) >> 6) : 0, nw = jhi - jlo + 1;
        m_run = NEGV; l_run = 0.f; o0 = f32x16{}; o1 = f32x16{};
        for (int i = 0; i < nw; ++i) {
            const int j = jhi - i;
            if (i + 1 < nw) NSA_LOAD(kwb + (size_t)(j - 1) * 64 * N1, vwb + (size_t)(j - 1) * 64 * N1, N1);
            else if (nbg >= 0) { const int nk_ = (ntt * 32) >> 10; NSA_LOAD(kcmp + ((size_t)nbg * 512 + 64 * nk_) * 64, vcmp + ((size_t)nbg * 512 + 64 * nk_) * 64, 64); }
            { const float cbv = sl2 * (float)(64 * j - t + 4 * hi) - EREF();
              if (!NSA_BOUNDSKIP(cb, sl2, cbv, false)) {
                NSA_QK(cb, sl2, cbv);
                if (!((64 * j + 63 <= t0) && (64 * j > t0 + 31 - 512))) { const int lim = t - 64 * j - 4 * hi; NSA_MASK(lim, lim - 512); }
                float mx; NSA_ROWMAX(mx);
                if (!NSA_SKIPPABLE(mx)) { NSA_PV_PRE(cb); NSA_ONLINE(true, mx); NSA_PV_MAIN(); } } }
            if (i + 1 < nw || nbg >= 0) NSA_WRITE(NXT(cb));
            __syncthreads(); cb = NXT(cb);
        }
        const float il = NSA_GATE(2) * fast_rcp(both_sum(l_run));
        bf16* op = ocat + row * D + hq * 64 + 4 * hi;
#pragma unroll
        for (int rr = 0; rr < 4; ++rr) { float a[4], c[4];
#pragma unroll
            for (int e = 0; e < 4; ++e) { a[e] = OA[(4 * rr + e) * 512] + il * o0[4 * rr + e]; c[e] = OA[(16 + 4 * rr + e) * 512] + il * o1[4 * rr + e]; }
            *(GAS v2u*)(op + 8 * rr) = (v2u){pg8::cvt_pk_bf16(a[0], a[1]), pg8::cvt_pk_bf16(a[2], a[3])};
            *(GAS v2u*)(op + 32 + 8 * rr) = (v2u){pg8::cvt_pk_bf16(c[0], c[1]), pg8::cvt_pk_bf16(c[2], c[3])}; }
    }
    cbio = cb;
#undef NSA_GATE
#undef NSA_LOAD
#undef NSA_WRITE
#undef NSA_QK
#undef NSA_PV_PRE
#undef NSA_PV_MAIN
#undef NSA_VLD
#undef NSA_KLD
#undef NSA_SB
#undef NSA_VTR
#undef NSA_MASK
#undef NSA_ONLINE
#undef NSA_SKIPPABLE
#undef NSA_BOUNDSKIP
#undef EREF
#undef NSA_ROWMAX
#undef NXT
}
}

constexpr int N_PHASES = 20;
__global__ void __launch_bounds__(NTHR, 2) fwd_kernel(Ptrs P) {
    extern __shared__ __attribute__((aligned(16))) unsigned char lds[];
    Frame F;
    F.lds = (LAS unsigned char*)lds;
    F.tid = threadIdx.x; F.lane = F.tid & 63; F.wave = __builtin_amdgcn_readfirstlane(F.tid >> 6);
    F.G = gridDim.x; { const int bx = blockIdx.x; F.vcu = (F.G % 8 == 0) ? (bx % 8) * (F.G / 8) + bx / 8 : bx; }
    unsigned char* ws = P.ws;
    volatile LAS unsigned* MISC = (volatile LAS unsigned*)(F.lds + MISC_OFF);
    for (int u = F.tid; u < (LDS_BYTES - LDSCTL_OFF) / 4; u += NTHR) ((LAS unsigned*)(F.lds + LDSCTL_OFF))[u] = 0u;
    __syncthreads();
#if MK_ONE_LAUNCH
    XcdBarrier bar = xcd_barrier_post((unsigned*)(ws + WS_CTL) + 4096, MISC + 8);
#define GRID_BAR() xcd_barrier(bar)
#else
    (void)MISC;
#define GRID_BAR() do { } while (0)
#endif
#ifndef RES_ALIGN
#define RES_ALIGN true
#endif
    const int lo = P.ph_lo, hi = P.ph_hi;
#ifndef DUP_MASK
#define DUP_MASK 0
#endif
#define NREP(k) (((DUP_MASK >> (k)) & 1) ? 2 : 1)
#define IN(k) (lo <= (k) && (k) < hi)
#define SEAM(k) do { if (IN(k) && IN((k) + 1)) GRID_BAR(); { int t_ = threadIdx.x; asm volatile("" : "+v"(t_)); F.tid = t_; F.lane = t_ & 63; } } while (0)
    float* stats = (float*)(ws + WS_STATS);
    bf16* hb = (bf16*)(ws + WS_HB); bf16* hid = (bf16*)(ws + WS_BIG); bf16* ocat = (bf16*)(ws + WS_OCAT);

    if (IN(0)) { for (int rep = 0; rep < NREP(0); ++rep) p0_prologue(P, F); }
    SEAM(0);
#define FFN_UP(ph, idx) if (IN(ph)) { \
        pg8::Gemm g{hb, (const bf16*)(ws + WS_WGU) + (size_t)(idx) * (2 * FF) * D, D, D, 64, (size_t)256 * D, 0, D}; pg8::StaticOrder S; S.init(M, 2 * FF, F.G, (int)blockIdx.x); \
        pg8::EpiUp E{hid, stats, F.lds + RS_OFF}; pg8::gemm_phase<pg8::EpiUp, pg8::StaticOrder>(F.lds + RING_OFF, g, S, E); } SEAM(ph)
#define FFN_DOWN(ph, idx, basep) if (IN(ph)) { \
        pg8::Gemm g{hid, (const bf16*)(ws + WS_WD) + (size_t)(idx) * D * FF, FF, FF, 64, (size_t)256 * FF, 0, FF}; pg8::StaticOrder S; S.init(M, D, F.G, (int)blockIdx.x); \
        pg8::EpiRes E{hb, stats, 0.5f}; pg8::gemm_phase<pg8::EpiRes, pg8::StaticOrder, RES_ALIGN>(F.lds + RING_OFF, g, S, E); } SEAM(ph)
#define OUT_PROJ(ph, wptr) if (IN(ph)) { \
        pg8::Gemm g{ocat, (const bf16*)(wptr), D, D, 64, (size_t)256 * D, 0, D}; pg8::StaticOrder S; S.init(M, D, F.G, (int)blockIdx.x); \
        pg8::EpiRes E{hb, stats, 1.0f}; pg8::gemm_phase<pg8::EpiRes, pg8::StaticOrder, RES_ALIGN>(F.lds + RING_OFF, g, S, E); } SEAM(ph)

    FFN_UP(1, 0);
#if DUP_MASK & 2
#undef SEAM
#define SEAM(k) do { } while (0)
    FFN_UP(1, 0);
#undef SEAM
#define SEAM(k) do { if (IN(k) && IN((k) + 1)) GRID_BAR(); { int t_ = threadIdx.x; asm volatile("" : "+v"(t_)); F.tid = t_; F.lane = t_ & 63; } } while (0)
#endif
    FFN_DOWN(2, 0, P.x);
#if DUP_MASK & 8
    if (IN(3)) {
        pg8::Gemm g{hb, (const bf16*)(ws + WS_W0IN), D, D, 64, (size_t)256 * D, 0, D}; pg8::StaticOrder S; S.init(M, N0, F.G, (int)blockIdx.x);
        pg8::EpiProj E{(bf16*)(ws + WS_BIG), N0, stats, F.lds + RS_OFF}; pg8::gemm_phase<pg8::EpiProj, pg8::StaticOrder>(F.lds + RING_OFF, g, S, E); }
#endif
    if (IN(3)) {
        pg8::Gemm g{hb, (const bf16*)(ws + WS_W0IN), D, D, 64, (size_t)256 * D, 0, D}; pg8::StaticOrder S; S.init(M, N0, F.G, (int)blockIdx.x);
        pg8::EpiProj E{(bf16*)(ws + WS_BIG), N0, stats, F.lds + RS_OFF}; pg8::gemm_phase<pg8::EpiProj, pg8::StaticOrder>(F.lds + RING_OFF, g, S, E); }
    SEAM(3);
    if (IN(4)) {
        for (int rep = 0; rep < NREP(4); ++rep) { for (int u = F.vcu; u < 2048; u += F.G) gla_g1_unit(P, F, u); }
        if (F.vcu == 0) { const float* part = (const float*)(ws + WS_MISC); float* bias = (float*)(ws + WS_MISC + 128 * 1024); const int kv = F.tid >> 8, j = F.tid & 255; float s = 0.f;
            for (int ch = 0; ch < 32; ++ch) s += part[(kv * 32 + ch) * 256 + j];
            bias[F.tid] = s; }
    }
    SEAM(4);
    if (IN(5)) { if (F.tid < 256) gla_g2(P, F); else pool_phase(P, F, F.tid - 256, 256); }
    SEAM(5);
    if (IN(6)) { for (int rep = 0; rep < NREP(6); ++rep) for (int u = F.vcu; u < 2048; u += F.G) gla_g3_unit(P, F, u); }
    SEAM(6);
#if DUP_MASK & 128
    if (IN(7)) { pg8::Gemm g{ocat, (const bf16*)(ws + WS_W0OUT), D, D, 64, (size_t)256 * D, 0, D}; pg8::StaticOrder S; S.init(M, D, F.G, (int)blockIdx.x);
        pg8::EpiRes E{hb, stats, 0.0f}; pg8::gemm_phase<pg8::EpiRes, pg8::StaticOrder, RES_ALIGN>(F.lds + RING_OFF, g, S, E); }
#endif
    OUT_PROJ(7, ws + WS_W0OUT);
    FFN_UP(8, 1);
#if DUP_MASK & 512
    if (IN(9)) { pg8::Gemm g{hid, (const bf16*)(ws + WS_WD) + (size_t)(1) * D * FF, FF, FF, 64, (size_t)256 * FF, 0, FF}; pg8::StaticOrder S; S.init(M, D, F.G, (int)blockIdx.x);
        pg8::EpiRes E{hb, stats, 0.0f}; pg8::gemm_phase<pg8::EpiRes, pg8::StaticOrder, RES_ALIGN>(F.lds + RING_OFF, g, S, E); }
#endif
    FFN_DOWN(9, 1, P.out);
    FFN_UP(10, 2);
    FFN_DOWN(11, 2, P.out);
    if (IN(12)) {
        pg8::Gemm g{hb, (const bf16*)(ws + WS_W1IN), D, D, 64, (size_t)256 * D, 0, D}; pg8::StaticOrder S; S.init(M, N1, F.G, (int)blockIdx.x);
        pg8::EpiProj E{(bf16*)(ws + WS_BIG), N1, stats, F.lds + RS_OFF}; pg8::gemm_phase<pg8::EpiProj, pg8::StaticOrder>(F.lds + RING_OFF, g, S, E); }
    SEAM(12);
    if (IN(13)) {
        pg8::Gemm g{(const bf16*)(ws + WS_BIG), (const bf16*)(ws + WS_WC1), 256, 16 * N1, N1, 0, 1, 2048}; pg8::CmpOrder S{F.G, (int)blockIdx.x};
        pg8::EpiPart E{(float*)(ws + WS_OCAT)}; pg8::gemm_phase<pg8::EpiPart, pg8::CmpOrder>(F.lds + RING_OFF, g, S, E); }
    SEAM(13);
    if (IN(14)) { for (int rep = 0; rep < NREP(14); ++rep) cmp2_phase(P, F); }
    SEAM(14);
    if (IN(15)) { int cbio = 0;
        if (F.wave >= 4) __builtin_amdgcn_s_setprio(2);
        for (int i = 0; i * F.G + F.vcu < 2048; ++i) { const int u = i * F.G + F.vcu, un = u + F.G;
            nsa::nsa_unit(P, F, u >> 8, ((u & 255) + 32 * (u >> 8)) & 255, (un < 2048) ? (un >> 8) : -1, ((un & 255) + 32 * (un >> 8)) & 255, i == 0, cbio); }
        __builtin_amdgcn_s_setprio(0); }
    SEAM(15);
    OUT_PROJ(16, ws + WS_W1OUT);
    FFN_UP(17, 3);
    FFN_DOWN(18, 3, P.out);
    if (IN(19)) { final_norm_phase(P, F); }
#undef IN
#undef SEAM
}

extern "C" void kernel_launch(void* const* d_in, const int* in_sizes, int n_in, void* d_out, int out_size, void* d_ws, size_t ws_size, hipStream_t stream) {
    static int grid = 0;
    if (grid == 0) {
        if (n_in != 25 || in_sizes[0] != M * D || out_size != M * D || ws_size < WS_END) { fprintf(stderr, "kernel_launch: unexpected shapes (n_in %d, in0 %d, out %d, ws %zu)\n", n_in, n_in > 0 ? in_sizes[0] : -1, out_size, ws_size); grid = -1; return; }
        int dev = 0, cus = 0, per_cu = 0;
        if (hipGetDevice(&dev) != hipSuccess || hipDeviceGetAttribute(&cus, hipDeviceAttributeMultiprocessorCount, dev) != hipSuccess) { grid = -1; return; }
        if (hipFuncSetAttribute((const void*)fwd_kernel, hipFuncAttributeMaxDynamicSharedMemorySize, LDS_BYTES) != hipSuccess) { fprintf(stderr, "kernel_launch: hipFuncSetAttribute failed\n"); grid = -1; return; }
        if (hipOccupancyMaxActiveBlocksPerMultiprocessor(&per_cu, (const void*)fwd_kernel, NTHR, LDS_BYTES) != hipSuccess || per_cu < 1) fprintf(stderr, "kernel_launch: occupancy query reports %d\n", per_cu);
        (void)hipGetLastError();
        grid = cus;
    }
    if (grid < 0) return;
    (void)hipMemsetAsync((char*)d_ws + WS_CTL, 0, CTL_ZERO_BYTES, stream);
    Ptrs p{};
    const float** pp = (const float**)&p;
    for (int i = 0; i < 25; ++i) pp[i] = (const float*)d_in[i];
    p.out = (float*)d_out; p.ws = (unsigned char*)d_ws;
#if MK_ONE_LAUNCH
    p.ph_lo = 0; p.ph_hi = N_PHASES;
    hipLaunchKernelGGL(fwd_kernel, dim3(grid), dim3(NTHR), LDS_BYTES, stream, p);
#else
    for (int ph = 0; ph < N_PHASES; ++ph) { p.ph_lo = ph; p.ph_hi = ph + 1; hipLaunchKernelGGL(fwd_kernel, dim3(grid), dim3(NTHR), LDS_BYTES, stream, p); }
#endif
}
```

```cpp
#include <hip/hip_runtime.h>
#include <cstdio>
#include <cstdint>

#ifndef DIAG
#define DIAG 0
#endif
#ifndef MK_ONE_LAUNCH
#define MK_ONE_LAUNCH 1
#endif

namespace pg8 {
#define PG8_LAS __attribute__((address_space(3)))
typedef unsigned short bf16_t;
typedef short bf16x8 __attribute__((ext_vector_type(8)));
typedef float f32x4 __attribute__((ext_vector_type(4)));
typedef unsigned u32x4 __attribute__((ext_vector_type(4)));
constexpr int BM = 256, BK = 64, HALF = 128, HTB = HALF * BK * 2  , STAGE_BYTES = 8 * HTB, NXCD = 8, WGM = 8;

__host__ __device__ __forceinline__ int lds_byte(int r, int c) { const int st = (r >> 4) * 2 + (c >> 5), rr = r & 15, cc = c & 31, ob = rr * 64 + cc * 2; return st * 1024 + (ob ^ (((ob >> 9) & 1) << 5)); }
__host__ __device__ __forceinline__ void stage_rc(int b, int& R, int& C) { const int st = b / 1024, sb = b % 1024, swz = sb ^ (((sb >> 9) & 1) << 5); R = (st >> 1) * 16 + swz / 64; C = (st & 1) * 32 + (swz % 64) / 2; }
__host__ __device__ __forceinline__ int perm32(int rho) { const int n = rho >> 4, i = rho & 15; return 8 * (i >> 2) + 4 * n + (i & 3); }

struct Unit { int pm, pn; };
struct Gemm { const bf16_t* A; const bf16_t* Bt; int K; int lda; int akt; size_t atile; int cmp; int ldb;
    __device__ __forceinline__ size_t aoff(int pm) const {
        if (!cmp) return (size_t)pm * atile;
        const int ksl = pm >> 8, kv = (pm >> 4) & 1, b = (pm >> 2) & 3, gg = (pm >> 1) & 1, half = pm & 1;
        return ((size_t)b * 8192 + (size_t)half * 4096) * 2048 + 1024 + kv * 128 + gg * 64 + (size_t)ksl * 4 * 2048; }
    __device__ __forceinline__ size_t boff(const Unit& u) const { return cmp ? ((size_t)u.pn * 256 * ldb + (size_t)(u.pm >> 8) * 256) : (size_t)u.pn * 256 * ldb; }
};

struct StaticOrder {
    int nM, nN, nwg, G, c;
    __host__ __device__ void init(int M, int N, int G_, int c_) { nM = M / BM; nN = N / BM; nwg = nM * nN; G = G_; c = c_; }
    __host__ __device__ bool next(int i, Unit& u) const {
        const long L = (long)i * G + c; if (L >= nwg) return false;
        int wgid = (int)L; { const int q = nwg / NXCD, r = nwg % NXCD, xcd = wgid % NXCD, off = wgid / NXCD; wgid = (xcd < r ? xcd * (q + 1) : r * (q + 1) + (xcd - r) * q) + off; }
        const int nig = WGM * nN, gid = wgid / nig, fm = gid * WGM, gsz = (nM - fm) < WGM ? (nM - fm) : WGM;
        u.pm = fm + ((wgid % nig) % gsz); u.pn = (wgid % nig) / gsz; return true;
    }
};
struct CmpOrder {
    int G, c;
    __device__ bool next(int i, Unit& u) const { const int L = i * G + c; if (L >= 256) return false; u.pm = (L >> 3) | ((L & 7) << 8); u.pn = L >> 7; return true; }
};

__device__ __forceinline__ unsigned cvt_pk_bf16(float lo, float hi) { unsigned r; asm volatile("v_cvt_pk_bf16_f32 %0, %1, %2" : "=v"(r) : "v"(lo), "v"(hi)); return r; }

template <class Epi, class Sched, bool ALIGN_EPI = true>
__device__ __forceinline__ void gemm_phase(PG8_LAS unsigned char* lds, const Gemm g, const Sched& S, const Epi& E) {
    int tid_ = threadIdx.x; asm volatile("" : "+v"(tid_));
    const int tid = tid_, wid = __builtin_amdgcn_readfirstlane(tid >> 6), lane = tid & 63, wr = wid >> 2, wc = wid & 3, fr = lane & 15, fq = lane >> 4;
    const int K = g.K, nt = K / BK;
    unsigned voffA[2], voffB[2];
#pragma unroll
    for (int i = 0; i < 2; ++i) { int R, C; stage_rc(tid * 16 + i * 8192, R, C); const int Rb = Epi::PERM ? ((R & ~31) + perm32(R & 31)) : R;
        voffA[i] = (unsigned)(R * g.lda + C) * 2u; voffB[i] = (unsigned)(Rb * g.ldb + C) * 2u; }
    const size_t kstepA = (size_t)g.akt * 2, kstepB = (size_t)(BK * 2);
    const size_t hstepA = (size_t)HALF * g.lda * 2, hstepB = (size_t)HALF * g.ldb * 2;
    const unsigned ldsw = (unsigned)wid * 1024u;
    const int aoff = lds_byte(wr * 64 + fr, fq * 8), boff = lds_byte(wc * 32 + fr, fq * 8);
#define PG8_SA(b, h) (((b) * 2 + (h)) * HTB)
#define PG8_SB(b, h) ((4 + (b) * 2 + (h)) * HTB)
#define PG8_STAGE(bufoff, gbase, voff) do { _Pragma("unroll") for (int _i = 0; _i < 2; ++_i) \
        __builtin_amdgcn_global_load_lds((const unsigned*)((const char*)(gbase) + (voff)[_i]), (PG8_LAS unsigned*)(lds + (bufoff) + ldsw + _i * 8192), 16, 0, 0); } while (0)
#define PG8_LDA(dst, b, h) do { _Pragma("unroll") for (int m = 0; m < 4; ++m) _Pragma("unroll") for (int k = 0; k < 2; ++k) dst[m][k] = *(const PG8_LAS bf16x8*)(lds + PG8_SA(b, h) + aoff + m * 2048 + k * 1024); } while (0)
#define PG8_LDB(dst, b, h) do { _Pragma("unroll") for (int n = 0; n < 2; ++n) _Pragma("unroll") for (int k = 0; k < 2; ++k) dst[n][k] = *(const PG8_LAS bf16x8*)(lds + PG8_SB(b, h) + boff + n * 2048 + k * 1024); } while (0)
#define PG8_MMA(ai, bj, At, Bt) do { __builtin_amdgcn_s_setprio(1); _Pragma("unroll") for (int m = 0; m < 4; ++m) _Pragma("unroll") for (int n = 0; n < 2; ++n) _Pragma("unroll") for (int k = 0; k < 2; ++k) \
        acc[ai][bj][m][n] = __builtin_amdgcn_mfma_f32_16x16x32_bf16(Bt[n][k], At[m][k], acc[ai][bj][m][n], 0, 0, 0); __builtin_amdgcn_s_setprio(0); } while (0)
#define PG8_WAIT_V(n) asm volatile("s_waitcnt vmcnt(" #n ")" ::: "memory")
#define PG8_WAIT_L(n) asm volatile("s_waitcnt lgkmcnt(" #n ")" ::: "memory")
#define PG8_BAR __builtin_amdgcn_s_barrier()
#define PG8_SCHED __builtin_amdgcn_sched_barrier(0)
    Unit cur, nxt; int ui = 0;
    if (!S.next(0, cur)) return;
    f32x4 acc[2][2][4][2];
#pragma unroll
    for (int a = 0; a < 2; ++a)
#pragma unroll
        for (int b = 0; b < 2; ++b)
#pragma unroll
            for (int m = 0; m < 4; ++m)
#pragma unroll
                for (int n = 0; n < 2; ++n) acc[a][b][m][n] = (f32x4){0.f, 0.f, 0.f, 0.f};
    bf16x8 At[4][2], B0[2][2], B1[2][2];
    const char* cA = (const char*)g.A + g.aoff(cur.pm) * 2; const char* cB = (const char*)g.Bt + g.boff(cur) * 2;
    if constexpr (Epi::NEEDS_RS) {
        constexpr int MAXU = 12; f32x4 sa[MAXU], sb[MAXU]; bool ok[MAXU];
#pragma unroll
        for (int i = 0; i < MAXU; ++i) { Unit u_; ok[i] = S.next(i, u_); sa[i] = (f32x4){0.f, 0.f, 0.f, 0.f}; sb[i] = sa[i];
            if (ok[i]) { const float* sp_ = E.stats + ((size_t)(u_.pm * BM + (tid >> 1)) * 16 + (tid & 1) * 8); sa[i] = *(const f32x4*)sp_; sb[i] = *(const f32x4*)(sp_ + 4); } }
#pragma unroll
        for (int i = 0; i < MAXU; ++i) if (ok[i]) { float s_ = ((sa[i][0] + sa[i][1]) + (sa[i][2] + sa[i][3])) + ((sb[i][0] + sb[i][1]) + (sb[i][2] + sb[i][3]));
            s_ += __builtin_bit_cast(float, __builtin_amdgcn_mov_dpp(__builtin_bit_cast(int, s_), 0xB1, 0xf, 0xf, true));
            if ((tid & 1) == 0) ((PG8_LAS float*)(E.rs_lds + i * 1024))[tid >> 1] = __builtin_amdgcn_rsqf(s_ * (1.0f / 1024.0f) + 1e-6f); }
    }
    PG8_STAGE(PG8_SB(0, 0), cB, voffB); PG8_STAGE(PG8_SB(0, 1), cB + hstepB, voffB); PG8_STAGE(PG8_SA(0, 0), cA, voffA); PG8_STAGE(PG8_SA(0, 1), cA + hstepA, voffA);
    if (wr == 1) PG8_BAR;
    PG8_WAIT_V(2); PG8_BAR;
    PG8_STAGE(PG8_SB(1, 0), cB + kstepB, voffB); PG8_STAGE(PG8_SA(1, 0), cA + kstepA, voffA); PG8_STAGE(PG8_SB(1, 1), cB + hstepB + kstepB, voffB);
    PG8_WAIT_V(6); PG8_BAR;
    for (;;) {
        const bool has_next = S.next(ui + 1, nxt);
        const char* nA = has_next ? (const char*)g.A + g.aoff(nxt.pm) * 2 : cA; const char* nB = has_next ? (const char*)g.Bt + g.boff(nxt) * 2 : cB;
        for (int t = 0; t < nt; t += 2) {
            const bool last = (t == nt - 2);
            const char* a1 = cA + (size_t)(t + 1) * kstepA;
            const char* a2 = last ? nA : cA + (size_t)(t + 2) * kstepA; const char* b2 = last ? nB : cB + (size_t)(t + 2) * kstepB;
            const char* a3 = a2 + kstepA; const char* b3 = b2 + kstepB;
            PG8_LDB(B0, 0, 0); PG8_LDB(B1, 0, 1); PG8_SCHED; PG8_LDA(At, 0, 0); PG8_STAGE(PG8_SA(1, 1), a1 + hstepA, voffA);
            PG8_WAIT_V(8); PG8_WAIT_L(0); PG8_BAR; PG8_MMA(0, 0, At, B0); PG8_MMA(0, 1, At, B1); PG8_BAR; PG8_SCHED;
            PG8_LDA(At, 0, 1); PG8_STAGE(PG8_SB(0, 0), b2, voffB); PG8_STAGE(PG8_SB(0, 1), b2 + hstepB, voffB); PG8_STAGE(PG8_SA(0, 0), a2, voffA);
            PG8_WAIT_V(8); PG8_WAIT_L(0); PG8_BAR; PG8_MMA(1, 0, At, B0); PG8_MMA(1, 1, At, B1); PG8_BAR; PG8_SCHED;
            PG8_LDB(B0, 1, 0); PG8_LDB(B1, 1, 1); PG8_SCHED; PG8_LDA(At, 1, 0); PG8_STAGE(PG8_SA(0, 1), a2 + hstepA, voffA);
            PG8_WAIT_V(8); PG8_WAIT_L(0); PG8_BAR; PG8_MMA(0, 0, At, B0); PG8_MMA(0, 1, At, B1); PG8_BAR; PG8_SCHED;
            PG8_LDA(At, 1, 1); PG8_STAGE(PG8_SB(1, 0), b3, voffB); PG8_STAGE(PG8_SB(1, 1), b3 + hstepB, voffB); PG8_STAGE(PG8_SA(1, 0), a3, voffA);
            PG8_WAIT_V(8); PG8_WAIT_L(0); PG8_BAR; PG8_MMA(1, 0, At, B0); PG8_MMA(1, 1, At, B1); PG8_BAR; PG8_SCHED;
        }
        if constexpr (ALIGN_EPI) { if (wr == 0) PG8_BAR; }
        E(acc, cur, wr, wc, fr, fq, ui);
        if (!has_next) break;
#pragma unroll
        for (int a = 0; a < 2; ++a)
#pragma unroll
            for (int b = 0; b < 2; ++b)
#pragma unroll
                for (int m = 0; m < 4; ++m)
#pragma unroll
                    for (int n = 0; n < 2; ++n) acc[a][b][m][n] = (f32x4){0.f, 0.f, 0.f, 0.f};
        cur = nxt; cA = nA; cB = nB; ++ui;
        if constexpr (ALIGN_EPI) { if (wr == 1) PG8_BAR; }
    }
    PG8_WAIT_V(0);
    if constexpr (!ALIGN_EPI) { if (wr == 0) PG8_BAR; }
    PG8_BAR;
#undef PG8_SA
#undef PG8_SB
#undef PG8_STAGE
#undef PG8_LDA
#undef PG8_LDB
#undef PG8_MMA
#undef PG8_WAIT_V
#undef PG8_WAIT_L
#undef PG8_BAR
#undef PG8_SCHED
}
}
#ifndef PROBE_A
#define PROBE_A -1
#define PROBE_B -1
#endif

constexpr int NWAVES = 8, NTHR = 512;
constexpr int Bsz = 4, T = 8192, D = 1024, FF = 2816, M = Bsz * T;
constexpr int N0 = 2304;
constexpr int N1 = 2048;
constexpr float EPS = 1e-6f;
constexpr float LOG2E = 1.4426950408889634f;

constexpr size_t MiB = 1u << 20;
constexpr size_t WS_CTL = 0, CTL_ZERO_BYTES = 1 * MiB;
constexpr size_t WS_STATS = 1 * MiB;
constexpr size_t WS_MISC = 3 * MiB;
constexpr size_t WS_WGU = 4 * MiB;
constexpr size_t WS_WD = 48 * MiB;
constexpr size_t WS_W0IN = 70 * MiB;
constexpr size_t WS_W0OUT = 75 * MiB;
constexpr size_t WS_W1IN = 77 * MiB;
constexpr size_t WS_W1OUT = 81 * MiB;
constexpr size_t WS_WC1 = 83 * MiB;
constexpr size_t WS_HB = 86 * MiB;
constexpr size_t WS_BIG = 150 * MiB;
constexpr size_t WS_X2 = 326 * MiB;
constexpr size_t WS_DECAY = 390 * MiB;
constexpr size_t WS_OCAT = 391 * MiB;
constexpr size_t WS_SPT = 456 * MiB;
constexpr size_t WS_END = 488 * MiB;

constexpr int RING_OFF = 0, RING_BYTES = 131072;
constexpr int RS_OFF = RING_BYTES;
constexpr int LDS_BYTES = 147456;
constexpr int LDSCTL_OFF = LDS_BYTES - 1024, MISC_OFF = LDSCTL_OFF + 320;

#define GAS __attribute__((address_space(1)))
#define LAS __attribute__((address_space(3)))
typedef unsigned short bf16;
typedef unsigned v4u __attribute__((ext_vector_type(4)));
typedef unsigned v2u __attribute__((ext_vector_type(2)));
typedef float f32x4 __attribute__((ext_vector_type(4)));
typedef float f32x16 __attribute__((ext_vector_type(16)));
typedef short bf16x8 __attribute__((ext_vector_type(8)));
typedef GAS unsigned gu32;
#define RLX_AGENT __ATOMIC_RELAXED, __HIP_MEMORY_SCOPE_AGENT
#define LDS_WAIT() asm volatile("s_waitcnt lgkmcnt(0)" ::: "memory")
#define VM_WAIT() asm volatile("s_waitcnt vmcnt(0)" ::: "memory")
__device__ __forceinline__ unsigned f2bf(float f) { unsigned u = __builtin_bit_cast(unsigned, f); return (u + 0x7fffu + ((u >> 16) & 1u)) >> 16; }
__device__ __forceinline__ unsigned pk2(float lo, float hi) { return f2bf(lo) | (f2bf(hi) << 16); }
__device__ __forceinline__ float bf2f(unsigned short b) { return __builtin_bit_cast(float, (unsigned)b << 16); }
__device__ __forceinline__ float bflo(unsigned w) { return __builtin_bit_cast(float, w << 16); }
__device__ __forceinline__ float bfhi(unsigned w) { return __builtin_bit_cast(float, w & 0xffff0000u); }
__device__ __forceinline__ float fast_exp2(float x) { return __builtin_amdgcn_exp2f(x); }
__device__ __forceinline__ float fast_rcp(float x) { return __builtin_amdgcn_rcpf(x); }
__device__ __forceinline__ float sigmoidf_(float x) { return fast_rcp(1.0f + fast_exp2(-x * LOG2E)); }
__device__ __forceinline__ float siluf_(float x) { return x * sigmoidf_(x); }
__device__ __forceinline__ float wave_sum(float v) {
#pragma unroll
    for (int o = 1; o < 64; o <<= 1) v += __shfl_xor(v, o);
    return v;
}

namespace pg8 {
typedef float f32x2v __attribute__((ext_vector_type(2)));
__device__ __forceinline__ void row_scales(const PG8_LAS unsigned char* tab, int wr, int fr, float (&rs)[2][4]) {
#pragma unroll
    for (int ai = 0; ai < 2; ++ai)
#pragma unroll
        for (int m = 0; m < 4; ++m) rs[ai][m] = ((const PG8_LAS float*)tab)[ai * HALF + wr * 64 + m * 16 + fr];
}
struct EpiUp {
    static constexpr bool PERM = true, NEEDS_RS = true;
    bf16_t* H; const float* stats; PG8_LAS unsigned char* rs_lds;
    __device__ __forceinline__ void operator()(const f32x4 (&acc)[2][2][4][2], const Unit& u, int wr, int wc, int fr, int fq, int slot) const {
        const int row0 = u.pm * BM + wr * 64 + fr; const PG8_LAS float* tab = (const PG8_LAS float*)(rs_lds + slot * 1024) + wr * 64 + fr;
        const int col0 = u.pn * 128 + wc * 32 + 8 * fq;
#pragma unroll
        for (int ai = 0; ai < 2; ++ai)
#pragma unroll
            for (int m = 0; m < 4; ++m) { const float s = tab[ai * HALF + m * 16]; float o[8];
                const f32x2v sneg = (f32x2v){-s * LOG2E, -s * LOG2E}, s2 = (f32x2v){s * s, s * s}, one = (f32x2v){1.f, 1.f};
#pragma unroll
                for (int n = 0; n < 2; ++n)
#pragma unroll
                    for (int i = 0; i < 4; i += 2) { const f32x2v gv = (f32x2v){acc[ai][0][m][n][i], acc[ai][0][m][n][i + 1]}, uv = (f32x2v){acc[ai][1][m][n][i], acc[ai][1][m][n][i + 1]};
                        const f32x2v tt = gv * sneg; f32x2v e; e.x = fast_exp2(tt.x); e.y = fast_exp2(tt.y); const f32x2v dd = e + one; f32x2v r; r.x = fast_rcp(dd.x); r.y = fast_rcp(dd.y);
                        const f32x2v res = (gv * uv) * (r * s2); o[n * 4 + i] = res.x; o[n * 4 + i + 1] = res.y;
#ifdef EPI_X
                        { const f32x2v t2 = uv * sneg; f32x2v e2; e2.x = fast_exp2(t2.x); e2.y = fast_exp2(t2.y); const f32x2v d2 = e2 + one; f32x2v r2; r2.x = fast_rcp(d2.x); r2.y = fast_rcp(d2.y); const f32x2v q2 = (gv * uv) * (r2 * s2); asm volatile("" :: "v"(q2.x), "v"(q2.y)); }
#endif
                    }
                u32x4 w; w.x = cvt_pk_bf16(o[0], o[1]); w.y = cvt_pk_bf16(o[2], o[3]); w.z = cvt_pk_bf16(o[4], o[5]); w.w = cvt_pk_bf16(o[6], o[7]);
                *(u32x4*)(H + (size_t)(row0 + ai * HALF + m * 16) * FF + col0) = w; }
    }
};
struct EpiRes {
    static constexpr bool PERM = true, NEEDS_RS = false;
    bf16_t* hb; float* stats; float coef; int knob = 0;
    __device__ __forceinline__ void operator()(const f32x4 (&acc)[2][2][4][2], const Unit& u, int wr, int wc, int fr, int fq, int) const {
        if (knob & 65536) return;
        const int row0 = u.pm * BM + wr * 64 + fr, col0 = u.pn * BM + wc * 32 + 8 * fq;
        u32x4 rr[2][4][2];
#pragma unroll
        for (int ai = 0; ai < 2; ++ai)
#pragma unroll
            for (int m = 0; m < 4; ++m)
#pragma unroll
                for (int bj = 0; bj < 2; ++bj) rr[ai][m][bj] = (knob & 131072) ? (u32x4){0u, 0u, 0u, 0u} : *(const u32x4*)(hb + (size_t)(row0 + ai * HALF + m * 16) * D + col0 + bj * HALF);
#pragma unroll
        for (int ai = 0; ai < 2; ++ai)
#pragma unroll
            for (int m = 0; m < 4; ++m) { const int row = row0 + ai * HALF + m * 16; const size_t off = (size_t)row * D + col0; float ss = 0.f;
#pragma unroll
                for (int bj = 0; bj < 2; ++bj) {
                    const u32x4 r = rr[ai][m][bj];
                    const f32x4 r0 = (f32x4){bflo(r.x), bfhi(r.x), bflo(r.y), bfhi(r.y)}, r1 = (f32x4){bflo(r.z), bfhi(r.z), bflo(r.w), bfhi(r.w)};
                    const f32x4 v0 = r0 + acc[ai][bj][m][0] * coef, v1 = r1 + acc[ai][bj][m][1] * coef;
                    u32x4 w; w.x = cvt_pk_bf16(v0[0], v0[1]); w.y = cvt_pk_bf16(v0[2], v0[3]); w.z = cvt_pk_bf16(v1[0], v1[1]); w.w = cvt_pk_bf16(v1[2], v1[3]);
                    if (!(knob & 524288)) *(u32x4*)(hb + off + bj * HALF) = w;
                    ss += (v0[0] * v0[0] + v0[1] * v0[1]) + (v0[2] * v0[2] + v0[3] * v0[3]) + (v1[0] * v1[0] + v1[1] * v1[1]) + (v1[2] * v1[2] + v1[3] * v1[3]); }
                if (!(knob & 262144)) { ss += __shfl_xor(ss, 16); ss += __shfl_xor(ss, 32);
                if (fq == 0) stats[(size_t)row * 16 + u.pn * 4 + wc] = ss; } }
    }
};
struct EpiProj {
    static constexpr bool PERM = true, NEEDS_RS = true;
    bf16_t* O; int ldc; const float* stats; PG8_LAS unsigned char* rs_lds;
    __device__ __forceinline__ void operator()(const f32x4 (&acc)[2][2][4][2], const Unit& u, int wr, int wc, int fr, int fq, int slot) const {
        const int row0 = u.pm * BM + wr * 64 + fr; const PG8_LAS float* tab = (const PG8_LAS float*)(rs_lds + slot * 1024) + wr * 64 + fr;
        const int col0 = u.pn * BM + wc * 32 + 8 * fq;
#pragma unroll
        for (int ai = 0; ai < 2; ++ai)
#pragma unroll
            for (int m = 0; m < 4; ++m) { const float s = tab[ai * HALF + m * 16]; bf16_t* rowp = O + (size_t)(row0 + ai * HALF + m * 16) * ldc + col0;
#pragma unroll
                for (int bj = 0; bj < 2; ++bj) { const f32x4 v0 = acc[ai][bj][m][0] * s, v1 = acc[ai][bj][m][1] * s;
                    u32x4 w; w.x = cvt_pk_bf16(v0[0], v0[1]); w.y = cvt_pk_bf16(v0[2], v0[3]); w.z = cvt_pk_bf16(v1[0], v1[1]); w.w = cvt_pk_bf16(v1[2], v1[3]);
                    *(u32x4*)(rowp + bj * HALF) = w; } }
    }
};
__device__ __forceinline__ float gelu_tanh_(float x) { const float y = 1.5957691216057308f * (x + 0.044715f * x * x * x); return x * fast_rcp(1.0f + fast_exp2(-y * LOG2E)); }
struct EpiPart {
    static constexpr bool PERM = true, NEEDS_RS = false;
    float* part;
    __device__ __forceinline__ void operator()(const f32x4 (&acc)[2][2][4][2], const Unit& u, int wr, int wc, int fr, int fq, int) const {
        const int row0 = (u.pm & 255) * BM + wr * 64 + fr, col0 = wc * 32 + 8 * fq; float* base = part + (size_t)(u.pm >> 8) * 8192 * 256;
#pragma unroll
        for (int ai = 0; ai < 2; ++ai)
#pragma unroll
            for (int m = 0; m < 4; ++m) { float* rowp = base + (size_t)(row0 + ai * HALF + m * 16) * 256 + col0;
#pragma unroll
                for (int bj = 0; bj < 2; ++bj) { *(f32x4*)(rowp + bj * HALF) = acc[ai][bj][m][0]; *(f32x4*)(rowp + bj * HALF + 4) = acc[ai][bj][m][1]; } }
    }
};
}
#define XB_TMO      128
#define XB_XCNT(j)  (256  + 64 * (j))
#define XB_XSUB(j)  (1280 + 64 * (j))
#define XB_XGEN(j)  (2304 + 64 * (j))
#define XB_TOP      3328
#define XB_TOPGEN   3392
#define XCD_BAR_WORDS 3456
#define XB_SPIN_CAP (1u << 18)

__device__ __forceinline__ unsigned xb_ld(unsigned* p)              { return __hip_atomic_load(p, __ATOMIC_RELAXED, __HIP_MEMORY_SCOPE_AGENT); }
__device__ __forceinline__ unsigned xb_add(unsigned* p, unsigned v) { return __hip_atomic_fetch_add(p, v, __ATOMIC_RELAXED, __HIP_MEMORY_SCOPE_AGENT); }
__device__ __forceinline__ unsigned xb_xcc_id() { return (unsigned)__builtin_amdgcn_s_getreg((3 << 11) | 20) & 0xFu; }
#define XB_SPIN(cond, bar) do { unsigned _sp = 0; while (cond) { __builtin_amdgcn_s_sleep(1); \
    if ((++_sp & 255u) == 0u) { if (xb_ld(&(bar)[XB_TMO])) break; if (_sp > XB_SPIN_CAP) { atomicAdd(&(bar)[XB_TMO], 1u); break; } } } } while (0)

struct XcdBarrier {
    unsigned* bar; unsigned x;
    volatile LAS unsigned* st;
};

__device__ __forceinline__ XcdBarrier xcd_barrier_post(unsigned* bar, volatile LAS unsigned* st) {
    XcdBarrier b; b.bar = bar; b.x = xb_xcc_id(); b.st = st;
    if (threadIdx.x == 0) (void)xb_add(&bar[XB_XCNT(b.x)], 1u);
    return b;
}
__device__ __forceinline__ void xcd_barrier_complete(unsigned* bar, unsigned x, unsigned& nloc, unsigned& nx) {
    const unsigned G = gridDim.x * gridDim.y * gridDim.z;
    unsigned sum, cnt, mine, sp = 0u;
    for (;;) {
        sum = 0u; cnt = 0u; mine = 0u;
#pragma unroll
        for (unsigned j = 0; j < 16; ++j) { const unsigned c = xb_ld(&bar[XB_XCNT(j)]); sum += c; cnt += (c > 0u) ? 1u : 0u; mine = (j == x) ? c : mine; }
        if (sum == G) break;
        __builtin_amdgcn_s_sleep(1);
        if ((++sp & 255u) == 0u) { if (xb_ld(&bar[XB_TMO])) break; if (sp > XB_SPIN_CAP) { atomicAdd(&bar[XB_TMO], 1u); break; } }
    }
    nloc = mine > 0u ? mine : 1u; nx = cnt > 0u ? cnt : 1u;
}

__device__ __forceinline__ void xcd_barrier(const XcdBarrier& b) {
    asm volatile("s_waitcnt vmcnt(0)" ::: "memory");
    __syncthreads();
    if (threadIdx.x == 0) {
        unsigned* bar = b.bar;
        __builtin_amdgcn_s_waitcnt(0);
        unsigned nloc = b.st[0], nx = b.st[1];
        if (nloc == 0u) { xcd_barrier_complete(bar, b.x, nloc, nx); b.st[0] = nloc; b.st[1] = nx; }
        const unsigned old = xb_add(&bar[XB_XSUB(b.x)], 1u);
        const unsigned gen = old / nloc;
        if (old + 1u == (gen + 1u) * nloc) {
            __builtin_amdgcn_fence(__ATOMIC_RELEASE, "agent");
            asm volatile("s_waitcnt vmcnt(0)" ::: "memory");
            const unsigned og = xb_add(&bar[XB_TOP], 1u);
            const unsigned tg = og / nx;
            if (og + 1u == (tg + 1u) * nx) xb_add(&bar[XB_TOPGEN], 1u);
            else XB_SPIN(xb_ld(&bar[XB_TOPGEN]) == tg, bar);
            __builtin_amdgcn_fence(__ATOMIC_ACQUIRE, "agent");
            xb_add(&bar[XB_XGEN(b.x)], 1u);
            asm volatile("s_waitcnt vmcnt(0)" ::: "memory");
        } else {
            XB_SPIN(xb_ld(&bar[XB_XGEN(b.x)]) == gen, bar);
            __builtin_amdgcn_fence(__ATOMIC_ACQUIRE, "agent");
            asm volatile("s_waitcnt vmcnt(0)" ::: "memory");
        }
    }
    __syncthreads();
}

struct Ptrs {
    const float* x; const float* norm_ffn1; const float* ffn1_wg; const float* ffn1_wu; const float* ffn1_wd; const float* norm_mix; const float* norm_ffn2;
    const float* ffn2_wg; const float* ffn2_wu; const float* ffn2_wd; const float* a_w_in; const float* a_gate_w2; const float* a_gate_b; const float* a_gla_norm;
    const float* a_pool_w; const float* a_pool_scale; const float* a_w_out; const float* c_w_in; const float* c_cmp_pe; const float* c_cmpk_w1; const float* c_cmpk_w2;
    const float* c_cmpv_w1; const float* c_cmpv_w2; const float* c_w_out; const float* final_norm;
    float* out; unsigned char* ws; int ph_lo, ph_hi;
#ifdef PROBE_KNOB
    int knob;
#endif
};
struct Frame {
    LAS unsigned char* lds;
    int tid, lane, wave, vcu, G;
};

__device__ __forceinline__ void transpose_item(const float* W, int ldw, int col0, int K, int nvalid, const float* gain, float coef, bf16* WT, int drow0, int mode,
                                               LAS float* scr, int item, int nblk, int lane) {
    const int kb = item / nblk, nb = item % nblk, k0 = 64 * kb, n0 = 32 * nb;
    const int nn = lane & 31; const bool ok = (n0 + nn) < nvalid;
    float v[32];
    const float* src = W + (size_t)(k0 + (lane >> 5)) * ldw + col0 + n0 + (ok ? nn : 0);
#pragma unroll
    for (int i = 0; i < 32; ++i) v[i] = src[(size_t)(2 * i) * ldw];
    if (gain) {
#pragma unroll
        for (int i = 0; i < 32; ++i) v[i] *= gain[k0 + 2 * i + (lane >> 5)];
    }
#pragma unroll
    for (int i = 0; i < 32; ++i) scr[(2 * i + (lane >> 5)) * 33 + nn] = ok ? v[i] * coef : 0.f;
    LDS_WAIT(); asm volatile("" ::: "memory");
    const int c = lane & 7;
    int dbase = drow0 + n0; if (mode == 1) dbase = drow0 + (n0 >> 7) * 256 + (n0 & 127); else if (mode == 2) dbase = drow0 + (n0 >> 7) * 256 + 128 + (n0 & 127);
#pragma unroll
    for (int j = 0; j < 4; ++j) { const int n = (lane >> 3) + 8 * j; const LAS float* s = scr + (8 * c) * 33 + n;
        v4u o; o.x = pk2(s[0 * 33], s[1 * 33]); o.y = pk2(s[2 * 33], s[3 * 33]); o.z = pk2(s[4 * 33], s[5 * 33]); o.w = pk2(s[6 * 33], s[7 * 33]);
        *(GAS v4u*)(WT + (size_t)(dbase + n) * K + k0 + 8 * c) = o; }
    LDS_WAIT(); asm volatile("" ::: "memory");
}
struct TJob { const float* W; int ldw, col0, K, ncols, nvalid; const float* gain; float coef; bf16* WT; int drow0, mode; };
__device__ __forceinline__ void get_job(const Ptrs& P, int id, TJob& j) {
    unsigned char* ws = P.ws;
    j.col0 = 0; j.gain = nullptr; j.coef = 1.f; j.drow0 = 0; j.mode = 0;
    if (id < 8) {
        const int idx = id & 3, l = idx >> 1, f = idx & 1; const bool up = id >= 4;
        j.W = (f == 0 ? (up ? P.ffn1_wu : P.ffn1_wg) : (up ? P.ffn2_wu : P.ffn2_wg)) + (size_t)l * D * FF; j.ldw = FF; j.K = D; j.ncols = FF; j.nvalid = FF;
        j.gain = (f == 0 ? P.norm_ffn1 : P.norm_ffn2) + l * D; j.WT = (bf16*)(ws + WS_WGU) + (size_t)idx * (2 * FF) * D; j.mode = up ? 2 : 1;
    } else if (id < 12) {
        const int idx = id - 8, l = idx >> 1, f = idx & 1;
        j.W = (f == 0 ? P.ffn1_wd : P.ffn2_wd) + (size_t)l * FF * D; j.ldw = D; j.K = FF; j.ncols = D; j.nvalid = D; j.WT = (bf16*)(ws + WS_WD) + (size_t)idx * D * FF;
    } else if (id == 12) {
        j.W = P.a_w_in; j.ldw = 2064; j.K = D; j.ncols = 256; j.nvalid = 256; j.gain = P.norm_mix; j.coef = 0.125f; j.WT = (bf16*)(ws + WS_W0IN);
    } else if (id == 13) {
        j.W = P.a_w_in; j.ldw = 2064; j.col0 = 256; j.K = D; j.ncols = 1280; j.nvalid = 1280; j.gain = P.norm_mix; j.WT = (bf16*)(ws + WS_W0IN); j.drow0 = 256;
    } else if (id == 14) {
        j.W = P.a_w_out; j.ldw = D; j.K = D; j.ncols = D; j.nvalid = D; j.WT = (bf16*)(ws + WS_W0OUT);
    } else if (id == 15) {
        j.W = P.c_w_in; j.ldw = 1840; j.K = D; j.ncols = 1024; j.nvalid = 1024; j.gain = P.norm_mix + D; j.coef = 0.125f * LOG2E; j.WT = (bf16*)(ws + WS_W1IN);
    } else if (id == 16) {
        j.W = P.c_w_in; j.ldw = 1840; j.col0 = 1024; j.K = D; j.ncols = 1024; j.nvalid = 816; j.gain = P.norm_mix + D; j.WT = (bf16*)(ws + WS_W1IN); j.drow0 = 1024;
    } else if (id == 17) {
        j.W = P.c_w_out; j.ldw = D; j.K = D; j.ncols = D; j.nvalid = D; j.WT = (bf16*)(ws + WS_W1OUT);
    } else if (id == 18) {
        j.W = P.c_cmpk_w1; j.ldw = 256; j.K = 2048; j.ncols = 256; j.nvalid = 256; j.WT = (bf16*)(ws + WS_WC1);
    } else {
        j.W = P.c_cmpv_w1; j.ldw = 256; j.K = 2048; j.ncols = 256; j.nvalid = 256; j.WT = (bf16*)(ws + WS_WC1); j.drow0 = 256;
    }
}
constexpr int N_TJOBS = 20;
__host__ __device__ constexpr int p0_job_items(int id) {
    return id < 8 ? (D / 64) * (FF / 32) : id < 12 ? (FF / 64) * (D / 32) : id == 12 ? 16 * 8 : id == 13 ? 16 * 40 : id == 14 ? 16 * 32 : id == 15 ? 16 * 32 : id == 16 ? 16 * 32 : id == 17 ? 16 * 32 : 32 * 8; }
__host__ __device__ constexpr int p0_total_items() { int t = 0; for (int q = 0; q < N_TJOBS; ++q) t += p0_job_items(q); return t; }
constexpr int P0_NITEMS = p0_total_items();


#ifdef PROBE_KNOB
#define P0_KNOB_A ((P.knob & (1 << 22)) != 0)
#define P0_KNOB_E ((P.knob & (1 << 23)) ? M : gw)
#else
#define P0_KNOB_A false
#define P0_KNOB_E gw
#endif
__device__ __forceinline__ void p0_prologue(const Ptrs& P, Frame& F) {
    unsigned char* ws = P.ws;
    LAS float* scr = (LAS float*)(F.lds + RING_OFF + F.wave * 16384);
    const int gw = F.vcu * NWAVES + F.wave, NGW = F.G * NWAVES;
#ifndef P0_DUP
#define P0_DUP 0
#endif
    bf16* W0IN = (bf16*)(ws + WS_W0IN);
    const int rot_ = F.wave % 3;
    for (int st_ = 0; st_ < 3; ++st_) { const int sec_ = (st_ + rot_) % 3;
    if (sec_ == 0) {
    for (int rep = 0; rep < ((P0_DUP & 1) ? 2 : 1); ++rep)
    for (int gi = P0_KNOB_A ? (1 << 30) : gw; gi < P0_NITEMS; gi += NGW) {
        int id = 0, base = 0, cum = 0;
#pragma unroll
        for (int q = 0; q < N_TJOBS - 1; ++q) { cum += p0_job_items(q); if (gi >= cum) { id = q + 1; base = cum; } }
        TJob j; get_job(P, id, j);
        const int nblk = j.ncols / 32;
        transpose_item(j.W, j.ldw, j.col0, j.K, j.nvalid, j.gain, j.coef, j.WT, j.drow0, j.mode, scr, gi - base, nblk, F.lane);
    }
    } else if (sec_ == 1) {
    for (int rep = 0; rep < ((P0_DUP & 2) ? 2 : 1); ++rep) {
    for (int it = gw; it < 256 * 16; it += NGW) {
        const int j = it >> 4, k = (it & 15) * 64 + F.lane; const float* wr = P.a_w_in + (size_t)k * 2064 + 1536; float s = 0.f;
#pragma unroll
        for (int r = 0; r < 16; ++r) s += wr[r] * P.a_gate_w2[r * 256 + j];
        W0IN[(size_t)(1536 + j) * D + k] = (bf16)f2bf(s * P.norm_mix[k]);
    }
    for (int it = gw; it < 512 * 4; it += NGW) {
        const int g = it & 3, k = 2 * (it >> 2) + (F.lane >> 5), d0 = 4 * (F.lane & 31);
        const float* wr = P.a_w_in + (size_t)k * 2064 + 1552 + 128 * g; const float* pw = P.a_pool_w + (size_t)g * 16384 + d0;
        f32x4 s = (f32x4){0.f, 0.f, 0.f, 0.f};
#pragma unroll 4
        for (int c = 0; c < 128; c += 4) { const f32x4 w4 = *(const f32x4*)(wr + c);
            s += w4.x * *(const f32x4*)(pw + (c + 0) * 128); s += w4.y * *(const f32x4*)(pw + (c + 1) * 128); s += w4.z * *(const f32x4*)(pw + (c + 2) * 128); s += w4.w * *(const f32x4*)(pw + (c + 3) * 128); }
        const float gmk = P.norm_mix[k]; const f32x4 ps = *(const f32x4*)(P.a_pool_scale + 128 * g + d0);
#pragma unroll
        for (int e = 0; e < 4; ++e) W0IN[(size_t)(1792 + 128 * g + d0 + e) * D + k] = (bf16)f2bf(s[e] * gmk * ps[e]);
    }
    float* part = (float*)(ws + WS_MISC);
    for (int it = gw; it < 2 * 32 * 4; it += NGW) {
        const int kv = it >> 7, ch = (it >> 2) & 31, j = (it & 3) * 64 + F.lane; const float* w1 = (kv ? P.c_cmpv_w1 : P.c_cmpk_w1) + (size_t)(ch * 64) * 256 + j; const float* pe = P.c_cmp_pe + ch * 64;
        float s = 0.f;
#pragma unroll 32
        for (int k = 0; k < 64; ++k) s += pe[k] * w1[(size_t)k * 256];
        part[(kv * 32 + ch) * 256 + j] = s;
    }
    }
    } else {
    bf16* hb = (bf16*)(ws + WS_HB); float* stats = (float*)(ws + WS_STATS);
    for (int rep = 0; rep < ((P0_DUP & 4) ? 2 : 1); ++rep)
    for (int m = P0_KNOB_E; m < M; m += NGW) {
        const GAS f32x4* xr = (const GAS f32x4*)(P.x + (size_t)m * D) + F.lane; f32x4 v[4]; float s = 0.f;
#pragma unroll
        for (int j = 0; j < 4; ++j) { v[j] = xr[64 * j]; s += (v[j].x * v[j].x + v[j].y * v[j].y) + (v[j].z * v[j].z + v[j].w * v[j].w); }
        s = wave_sum(s);
        GAS unsigned long long* o8 = (GAS unsigned long long*)(hb + (size_t)m * D) + F.lane;
#pragma unroll
        for (int j = 0; j < 4; ++j) o8[64 * j] = (unsigned long long)pk2(v[j].x, v[j].y) | ((unsigned long long)pk2(v[j].z, v[j].w) << 32);
        if (F.lane < 16) stats[(size_t)m * 16 + F.lane] = (F.lane == 0) ? s : 0.f;
    }
    } }
    { v4u* pad = (v4u*)(ws + WS_BIG + (size_t)M * N1 * 2); const int gt = F.vcu * NTHR + F.tid;
      if (gt < 16 * N1 * 2 / 16) pad[gt] = (v4u){0u, 0u, 0u, 0u}; }
}

constexpr int LP = 65;
constexpr int GL_TOT = 63744;
#define GL_BAR() asm volatile("s_waitcnt lgkmcnt(0)\n\ts_barrier" ::: "memory")
struct GlaIn { v4u vv[2], kk, qq; unsigned short zr[8]; float gb; bf16x8 sf[4]; v2u gw[4]; };
__device__ __forceinline__ void gla_load_z(const bf16* proj0, const float* gate_b, int row0, int h, const Frame& F, GlaIn& I) {
    const int d = F.tid & 63, ig = F.tid >> 6; I.gb = gate_b[64 * h + d];
    const unsigned short* zp = (const unsigned short*)(proj0 + (size_t)(row0 + 8 * ig) * N0 + 1536 + 64 * h + d);
#pragma unroll
    for (int r = 0; r < 8; ++r) I.zr[r] = zp[(size_t)r * N0];
}
__device__ __forceinline__ void gla_cumlog(const GlaIn& I, LAS float* LA, const Frame& F) {
    const int d = F.tid & 63, ig = F.tid >> 6; const float gb = I.gb; float pre[8];
#pragma unroll
    for (int r = 0; r < 8; ++r) pre[r] = __builtin_bit_cast(float, (unsigned)I.zr[r] << 16) + gb;
#pragma unroll
    for (int r = 0; r < 8; ++r) { const float zz = pre[r];
        const float e = fast_exp2(-fabsf(zz) * LOG2E); pre[r] = (fminf(zz, 0.f) - __builtin_amdgcn_logf(1.0f + e) * 0.6931471805599453f) * (1.0f / 16.0f); }
#pragma unroll
    for (int r = 1; r < 8; ++r) pre[r] += pre[r - 1];
    LAS float* TOT = (LAS float*)(F.lds + GL_TOT);
    TOT[ig * 64 + d] = pre[7];
    GL_BAR();
    float off = 0.f;
#pragma unroll
    for (int g2 = 0; g2 < 7; ++g2) off += (g2 < ig) ? TOT[g2 * 64 + d] : 0.f;
#pragma unroll
    for (int r = 0; r < 8; ++r) LA[(8 * ig + r) * LP + d] = pre[r] + off;
    GL_BAR();
}
constexpr int GL_VT = 16640, GL_XA = 35072, GL_KI = 44288, GL_ATT = 53504, GL_SS = 62720, GL_LD = 144;
__device__ __forceinline__ void gla_load_v(const bf16* proj0, int row0, int h, const Frame& F, v4u (&vv)[2]) {
    const int i = F.tid >> 3, v0 = (F.tid & 7) * 16;
#pragma unroll
    for (int q = 0; q < 2; ++q) vv[q] = *(const GAS v4u*)(proj0 + (size_t)(row0 + i) * N0 + 512 + 128 * h + v0 + 8 * q);
}
__device__ __forceinline__ void gla_write_vt(const Frame& F, const v4u (&vv)[2]) {
    const int i = F.tid >> 3, v0 = (F.tid & 7) * 16; LAS unsigned short* vt = (LAS unsigned short*)(F.lds + GL_VT) + i;
#pragma unroll
    for (int q = 0; q < 2; ++q) { const unsigned vw[4] = {vv[q].x, vv[q].y, vv[q].z, vv[q].w};
#pragma unroll
        for (int e = 0; e < 8; ++e) vt[(v0 + 8 * q + e) * (GL_LD / 2)] = (unsigned short)((e & 1) ? (vw[e >> 1] >> 16) : (vw[e >> 1] & 0xffffu)); }
}
__device__ __forceinline__ void gla_g1_load(const Ptrs& P, const Frame& F, int unit, GlaIn& I) {
    const bf16* proj0 = (const bf16*)(P.ws + WS_BIG); const int b = unit >> 9, h = (unit >> 7) & 3, n = unit & 127, row0 = b * T + 64 * n;
    gla_load_v(proj0, row0, h, F, I.vv);
    I.kk = *(const GAS v4u*)(proj0 + (size_t)(row0 + (F.tid >> 3)) * N0 + 256 + 64 * h + (F.tid & 7) * 8);
    gla_load_z(proj0, P.a_gate_b, row0, h, F, I);
}
__device__ __forceinline__ void gla_g1_unit(const Ptrs& P, Frame& F, int unit, const GlaIn& I) {
    float* dS = (float*)(P.ws + WS_X2); float* decay = (float*)(P.ws + WS_DECAY);
    LAS float* LA = (LAS float*)(F.lds);
    const v4u kk = I.kk;
    gla_cumlog(I, LA, F);
    { const int i = F.tid >> 3, d0 = (F.tid & 7) * 8;
      const unsigned kw[4] = {kk.x, kk.y, kk.z, kk.w};
      LAS unsigned short* ket = (LAS unsigned short*)(F.lds + GL_XA) + i;
#pragma unroll
      for (int e = 0; e < 8; ++e) { const float kv = (e & 1) ? bfhi(kw[e >> 1]) : bflo(kw[e >> 1]); ket[(d0 + e) * (GL_LD / 2)] = (unsigned short)f2bf(kv * __expf(LA[63 * LP + d0 + e] - LA[i * LP + d0 + e])); }
      gla_write_vt(F, I.vv);
      if (F.tid < 64) decay[(size_t)unit * 64 + F.tid] = __expf(LA[63 * LP + F.tid]); }
    GL_BAR();
    { const int r32 = F.lane & 31, hi = F.lane >> 5, mb = F.wave >> 1, nb = F.wave & 1; f32x16 acc = f32x16{};
      const LAS unsigned char* ap = F.lds + GL_VT + (32 * mb + r32) * GL_LD + 16 * hi; const LAS unsigned char* bp = F.lds + GL_XA + (32 * nb + r32) * GL_LD + 16 * hi;
#pragma unroll
      for (int ks = 0; ks < 4; ++ks) acc = __builtin_amdgcn_mfma_f32_32x32x16_bf16(*(const LAS bf16x8*)(ap + 32 * ks), *(const LAS bf16x8*)(bp + 32 * ks), acc, 0, 0, 0);
      float* op = dS + (size_t)unit * 8192 + (size_t)(32 * mb + 4 * hi) * 64 + 32 * nb + r32;
#pragma unroll
      for (int r = 0; r < 16; ++r) op[((r & 3) + 8 * (r >> 2)) * 64] = acc[r]; }
    GL_BAR();
}
__device__ __forceinline__ void gla_g2(const Ptrs& P, Frame& F) {
    const float* dS = (const float*)(P.ws + WS_X2); const float* decay = (const float*)(P.ws + WS_DECAY); bf16* SPT = (bf16*)(P.ws + WS_SPT);
    for (int e = F.vcu * NTHR + F.tid; e < 16 * 64 * 128; e += F.G * NTHR) {
        const int bh = e >> 13, vd = e & 8191, d = e & 63; float S0 = 0.f, S1 = 0.f;
        for (int n0 = 0; n0 < 128; n0 += 16) { float ds0[16], ds1[16], dc[16];
#pragma unroll
            for (int j = 0; j < 16; ++j) { const size_t u = (size_t)bh * 128 + n0 + j; ds0[j] = dS[u * 8192 + vd]; ds1[j] = dS[u * 8192 + vd + 256]; dc[j] = decay[u * 64 + d]; }
#pragma unroll
            for (int j = 0; j < 16; ++j) { const size_t u = (size_t)bh * 128 + n0 + j; SPT[u * 8192 + vd] = (bf16)f2bf(S0); SPT[u * 8192 + vd + 256] = (bf16)f2bf(S1); S0 = dc[j] * S0 + ds0[j]; S1 = dc[j] * S1 + ds1[j]; } }
    }
}
__device__ __forceinline__ void gla_g3_load(const Ptrs& P, const Frame& F, int unit, GlaIn& I) {
    const bf16* proj0 = (const bf16*)(P.ws + WS_BIG); const bf16* SPT = (const bf16*)(P.ws + WS_SPT);
    const int b = unit >> 9, h = (unit >> 7) & 3, n = unit & 127, row0 = b * T + 64 * n;
    const int r32 = F.lane & 31, hi = F.lane >> 5, ib = F.wave >> 2, vb = F.wave & 3;
#pragma unroll
    for (int ks = 0; ks < 4; ++ks) I.sf[ks] = *(const GAS bf16x8*)(SPT + (size_t)unit * 8192 + (size_t)(32 * vb + r32) * 64 + 16 * ks + 8 * hi);
    gla_load_v(proj0, row0, h, F, I.vv);
    I.qq = *(const GAS v4u*)(proj0 + (size_t)(row0 + (F.tid >> 3)) * N0 + 64 * h + (F.tid & 7) * 8);
    I.kk = *(const GAS v4u*)(proj0 + (size_t)(row0 + (F.tid >> 3)) * N0 + 256 + 64 * h + (F.tid & 7) * 8);
    gla_load_z(proj0, P.a_gate_b, row0, h, F, I);
    const bf16* gp = proj0 + (size_t)(row0 + 32 * ib + r32) * N0 + 1024 + 128 * h + 32 * vb + 4 * hi;
#pragma unroll
    for (int rr = 0; rr < 4; ++rr) I.gw[rr] = *(const GAS v2u*)(gp + 8 * rr);
}
__device__ __forceinline__ void gla_g3_unit(const Ptrs& P, Frame& F, int unit, const GlaIn& I) {
    bf16* ocat = (bf16*)(P.ws + WS_OCAT);
    const int b = unit >> 9, h = (unit >> 7) & 3, n = unit & 127, row0 = b * T + 64 * n;
    const int r32 = F.lane & 31, hi = F.lane >> 5, ib = F.wave >> 2, vb = F.wave & 3;
    LAS float* LA = (LAS float*)(F.lds);
    const v4u qq = I.qq, kk = I.kk;
    gla_cumlog(I, LA, F);
    { const int i = F.tid >> 3, d0 = (F.tid & 7) * 8;
      const unsigned qw[4] = {qq.x, qq.y, qq.z, qq.w};
      const unsigned kw[4] = {kk.x, kk.y, kk.z, kk.w};
      float qd[8], ki[8];
#pragma unroll
      for (int e = 0; e < 8; ++e) { const float bb = LA[i * LP + d0 + e]; const float qv = (e & 1) ? bfhi(qw[e >> 1]) : bflo(qw[e >> 1]), kv = (e & 1) ? bfhi(kw[e >> 1]) : bflo(kw[e >> 1]);
          qd[e] = qv * __expf(bb); ki[e] = kv * __expf(-bb); }
      *(LAS v4u*)(F.lds + GL_XA + i * GL_LD + d0 * 2) = (v4u){pk2(qd[0], qd[1]), pk2(qd[2], qd[3]), pk2(qd[4], qd[5]), pk2(qd[6], qd[7])};
      *(LAS v4u*)(F.lds + GL_KI + i * GL_LD + d0 * 2) = (v4u){pk2(ki[0], ki[1]), pk2(ki[2], ki[3]), pk2(ki[4], ki[5]), pk2(ki[6], ki[7])};
      gla_write_vt(F, I.vv); }
    GL_BAR();
    f32x16 acc = f32x16{};
    const LAS unsigned char* qp = F.lds + GL_XA + (32 * ib + r32) * GL_LD + 16 * hi;
    if (F.wave == 0 || F.wave == 2 || F.wave == 3) {
        const int jb = (F.wave == 3) ? 1 : 0, ib2 = (F.wave == 0) ? 0 : 1; f32x16 at = f32x16{};
        const LAS unsigned char* kp = F.lds + GL_KI + (32 * jb + r32) * GL_LD + 16 * hi; const LAS unsigned char* qp2 = F.lds + GL_XA + (32 * ib2 + r32) * GL_LD + 16 * hi;
#pragma unroll
        for (int ks = 0; ks < 4; ++ks) at = __builtin_amdgcn_mfma_f32_32x32x16_bf16(*(const LAS bf16x8*)(kp + 32 * ks), *(const LAS bf16x8*)(qp2 + 32 * ks), at, 0, 0, 0);
        const int i = 32 * ib2 + r32;
#pragma unroll
        for (int rr = 0; rr < 4; ++rr) { const int j0 = 32 * jb + 8 * rr + 4 * hi; float a[4];
#pragma unroll
            for (int e = 0; e < 4; ++e) a[e] = (j0 + e <= i) ? at[4 * rr + e] : 0.f;
            *(LAS v2u*)(F.lds + GL_ATT + i * GL_LD + j0 * 2) = (v2u){pk2(a[0], a[1]), pk2(a[2], a[3])}; }
    }
#pragma unroll
    for (int ks = 0; ks < 4; ++ks) acc = __builtin_amdgcn_mfma_f32_32x32x16_bf16(I.sf[ks], *(const LAS bf16x8*)(qp + 32 * ks), acc, 0, 0, 0);
    GL_BAR();
    { const LAS unsigned char* vp = F.lds + GL_VT + (32 * vb + r32) * GL_LD + 16 * hi; const LAS unsigned char* ap = F.lds + GL_ATT + (32 * ib + r32) * GL_LD + 16 * hi;
#pragma unroll
      for (int ks = 0; ks < 4; ++ks) if (ks < 2 || ib == 1) acc = __builtin_amdgcn_mfma_f32_32x32x16_bf16(*(const LAS bf16x8*)(vp + 32 * ks), *(const LAS bf16x8*)(ap + 32 * ks), acc, 0, 0, 0); }
    { float ssq = 0.f;
#pragma unroll
      for (int r = 0; r < 16; ++r) ssq += acc[r] * acc[r];
      ssq += __shfl_xor(ssq, 32);
      LAS float* SS = (LAS float*)(F.lds + GL_SS); const int i = 32 * ib + r32;
      if (hi == 0) SS[vb * 64 + i] = ssq;
      GL_BAR();
      const float tot = (SS[i] + SS[64 + i]) + (SS[128 + i] + SS[192 + i]); const float rs = __builtin_amdgcn_rsqf(tot * (1.0f / 128.0f) + EPS);
      bf16* op = ocat + (size_t)(row0 + i) * D + 128 * h + 32 * vb + 4 * hi; const float* gn = P.a_gla_norm + 32 * vb + 4 * hi;
#pragma unroll
      for (int rr = 0; rr < 4; ++rr) { const v2u gw = I.gw[rr]; const f32x4 nn = *(const f32x4*)(gn + 8 * rr);
          const float o0 = acc[4 * rr] * rs * nn[0] * siluf_(bflo(gw.x)), o1 = acc[4 * rr + 1] * rs * nn[1] * siluf_(bfhi(gw.x)), o2 = acc[4 * rr + 2] * rs * nn[2] * siluf_(bflo(gw.y)), o3 = acc[4 * rr + 3] * rs * nn[3] * siluf_(bfhi(gw.y));
          *(GAS v2u*)(op + 8 * rr) = (v2u){pk2(o0, o1), pk2(o2, o3)}; } }
    GL_BAR();
}
__device__ __forceinline__ void pool_phase(const Ptrs& P, Frame& F, int pt, int npt) {
    const bf16* proj0 = (const bf16*)(P.ws + WS_BIG); bf16* ocat = (bf16*)(P.ws + WS_OCAT);
    for (int it = F.vcu * npt + pt; it < (M / 16) * 64; it += F.G * npt) {
        const int seg = it >> 6, ch = it & 63, r0 = seg * 16, t0 = r0 & (T - 1), w = 2 << (ch >> 4);
        const bf16* src = proj0 + (size_t)r0 * N0 + 1792 + ch * 8; bf16* dst = ocat + (size_t)r0 * D + 512 + ch * 8;
        float sum[8];
#pragma unroll
        for (int e = 0; e < 8; ++e) sum[e] = 0.f;
        for (int q = 1; q < w; ++q) if (t0 - q >= 0) { const v4u pv = *(const GAS v4u*)(src - (size_t)q * N0); const unsigned pw[4] = {pv.x, pv.y, pv.z, pv.w};
#pragma unroll
            for (int e = 0; e < 8; ++e) sum[e] += (e & 1) ? bfhi(pw[e >> 1]) : bflo(pw[e >> 1]); }
#pragma unroll 4
        for (int i = 0; i < 16; ++i) { const int t = t0 + i; const int cnt = (t + 1 < w) ? t + 1 : w;
            const v4u pv = *(const GAS v4u*)(src + (size_t)i * N0); const unsigned pw[4] = {pv.x, pv.y, pv.z, pv.w}; float x[8];
#pragma unroll
            for (int e = 0; e < 8; ++e) { x[e] = (e & 1) ? bfhi(pw[e >> 1]) : bflo(pw[e >> 1]); sum[e] += x[e]; }
            const float inv = 1.0f / (float)cnt; v4u o;
            o.x = pk2(sum[0] * inv - x[0], sum[1] * inv - x[1]); o.y = pk2(sum[2] * inv - x[2], sum[3] * inv - x[3]);
            o.z = pk2(sum[4] * inv - x[4], sum[5] * inv - x[5]); o.w = pk2(sum[6] * inv - x[6], sum[7] * inv - x[7]);
            *(GAS v4u*)(dst + (size_t)i * D) = o;
            if (t - w + 1 >= 0) { const v4u qv = *(const GAS v4u*)(src + (size_t)(i - w + 1) * N0); const unsigned qw[4] = {qv.x, qv.y, qv.z, qv.w};
#pragma unroll
                for (int e = 0; e < 8; ++e) sum[e] -= (e & 1) ? bfhi(qw[e >> 1]) : bflo(qw[e >> 1]); } }
    }
}
__device__ __forceinline__ void cmp2_phase(const Ptrs& P, Frame& F) {
    const float* part = (const float*)(P.ws + WS_OCAT); const float* bias = (const float*)(P.ws + WS_MISC + 128 * 1024); bf16* kc = (bf16*)(P.ws + WS_X2 + 4 * MiB);
    LAS float* hs = (LAS float*)(F.lds) + F.wave * 256; const int gw = F.vcu * NWAVES + F.wave, NGW = F.G * NWAVES;
    for (int row = gw; row < 8192; row += NGW) {
        const int kv = row >> 12; f32x4 a = *(const f32x4*)(bias + kv * 256 + 4 * F.lane);
#pragma unroll
        for (int sl = 0; sl < 8; ++sl) a += *(const GAS f32x4*)(part + ((size_t)sl * 8192 + row) * 256 + 4 * F.lane);
        *(LAS f32x4*)(hs + 4 * F.lane) = (f32x4){pg8::gelu_tanh_(a[0]), pg8::gelu_tanh_(a[1]), pg8::gelu_tanh_(a[2]), pg8::gelu_tanh_(a[3])};
        LDS_WAIT(); asm volatile("" ::: "memory");
        const float* w2 = (kv ? P.c_cmpv_w2 : P.c_cmpk_w2) + F.lane; float s = 0.f;
#pragma unroll 4
        for (int j = 0; j < 256; j += 4) { const f32x4 hv = *(const LAS f32x4*)(hs + j); s += hv[0] * w2[(j + 0) * 64] + hv[1] * w2[(j + 1) * 64] + hv[2] * w2[(j + 2) * 64] + hv[3] * w2[(j + 3) * 64]; }
        if ((row & 511) == 511) s = 0.f;
        kc[(size_t)row * 64 + F.lane] = (bf16)f2bf(s);
        LDS_WAIT(); asm volatile("" ::: "memory");
    }
}
__device__ __forceinline__ void final_norm_phase(const Ptrs& P, Frame& F) {
    const float* stats = (const float*)(P.ws + WS_STATS); const bf16* hb = (const bf16*)(P.ws + WS_HB); const int gw = F.vcu * NWAVES + F.wave, NGW = F.G * NWAVES;
#if PROBE_A >= 0
    const unsigned long long* TS = (const unsigned long long*)(P.ws + WS_CTL + 65536);
    const float probe_scale = 1.0f + sqrtf((float)(TS[PROBE_B] - TS[PROBE_A]) / (float)(TS[19] - TS[0]));
#else
    const float probe_scale = 1.0f;
#endif
    for (int m = gw; m < M; m += NGW) {
        float s = (F.lane < 16) ? stats[(size_t)m * 16 + F.lane] : 0.f; s = wave_sum(s); const float rs = __builtin_amdgcn_rsqf(s * (1.0f / 1024.0f) + EPS) * probe_scale;
        const GAS v4u* hr = (const GAS v4u*)(hb + (size_t)m * D) + 2 * F.lane; GAS f32x4* xr = (GAS f32x4*)(P.out + (size_t)m * D) + 4 * F.lane; const GAS f32x4* gn = (const GAS f32x4*)P.final_norm + 4 * F.lane;
#pragma unroll
        for (int j = 0; j < 2; ++j) { const v4u h = hr[j];
            xr[2 * j] = (f32x4){bflo(h.x), bfhi(h.x), bflo(h.y), bfhi(h.y)} * rs * gn[2 * j]; xr[2 * j + 1] = (f32x4){bflo(h.z), bfhi(h.z), bflo(h.w), bfhi(h.w)} * rs * gn[2 * j + 1]; }
    }
}

namespace nsa {
typedef float f32x2 __attribute__((ext_vector_type(2)));
typedef short v4i16_t __attribute__((ext_vector_type(4)));
typedef float f32x4_t __attribute__((ext_vector_type(4)));
constexpr int NBUF = 2, KB_OFF = 0, KB_SZ = 8192, VB_OFF = NBUF * KB_SZ, V_ROW = 192, VB_SZ = 64 * V_ROW;
constexpr int IMP_OFF = VB_OFF + NBUF * VB_SZ;
constexpr int IMP_LD = 132;
constexpr int IMPT_OFF = IMP_OFF + 32 * IMP_LD * 4;
constexpr int IMPT_LD = 17;
constexpr int SELM_OFF = IMPT_OFF + 8 * 32 * IMPT_LD * 4;
constexpr int UL_OFF = SELM_OFF + 512 + 64;
constexpr int KMX_OFF = UL_OFF + 528;
constexpr int OA_OFF = UL_OFF + 576;
static_assert(OA_OFF + 32 * 512 * 4 <= LDSCTL_OFF, "NSA LDS map");
constexpr float NEGV = -1e30f;

#define NSA_DPP(x, CTRL) __builtin_bit_cast(float, __builtin_amdgcn_mov_dpp(__builtin_bit_cast(int, (x)), (CTRL), 0xf, 0xf, true))
__device__ __forceinline__ float sum8(float v) { v += NSA_DPP(v, 0xB1); v += NSA_DPP(v, 0x4E); v += NSA_DPP(v, 0x141); return v; }
typedef __bf16 bf16x2_t __attribute__((ext_vector_type(2)));
__device__ __forceinline__ float ksq8(const v4u& x) {
    const bf16x2_t a = __builtin_bit_cast(bf16x2_t, x.x), b = __builtin_bit_cast(bf16x2_t, x.y), c = __builtin_bit_cast(bf16x2_t, x.z), d = __builtin_bit_cast(bf16x2_t, x.w);
    return __builtin_amdgcn_fdot2_f32_bf16(d, d, __builtin_amdgcn_fdot2_f32_bf16(c, c, __builtin_amdgcn_fdot2_f32_bf16(b, b, __builtin_amdgcn_fdot2_f32_bf16(a, a, 0.f, false), false), false), false); }
__device__ __forceinline__ float max3(float a, float b, float c) { float r; asm("v_max3_f32 %0, %1, %2, %3" : "=v"(r) : "v"(a), "v"(b), "v"(c)); return r; }
__device__ __forceinline__ float wave_max(float v) {
    v = fmaxf(v, NSA_DPP(v, 0xB1)); v = fmaxf(v, NSA_DPP(v, 0x4E)); v = fmaxf(v, NSA_DPP(v, 0x141)); v = fmaxf(v, NSA_DPP(v, 0x128));
    const float a = __builtin_bit_cast(float, __builtin_amdgcn_readlane(__builtin_bit_cast(int, v), 0)), b = __builtin_bit_cast(float, __builtin_amdgcn_readlane(__builtin_bit_cast(int, v), 16));
    const float c = __builtin_bit_cast(float, __builtin_amdgcn_readlane(__builtin_bit_cast(int, v), 32)), d = __builtin_bit_cast(float, __builtin_amdgcn_readlane(__builtin_bit_cast(int, v), 48));
    return fmaxf(fmaxf(a, b), fmaxf(c, d));
}
__device__ __forceinline__ void swap32(float v, float& a, float& b) {
    a = v; b = v;
    asm volatile("s_nop 1\n\tv_permlane32_swap_b32 %0, %1\n\ts_nop 1" : "+v"(a), "+v"(b));
}
__device__ __forceinline__ float partner(float v) { float a, b; swap32(v, a, b); return (threadIdx.x & 32) ? a : b; }
__device__ __forceinline__ float both_max(float v) { float a, b; swap32(v, a, b); return fmaxf(a, b); }
__device__ __forceinline__ float both_sum(float v) { float a, b; swap32(v, a, b); return a + b; }

#if DIAG
#define NSA_FLAG(cond, bitv) do { if (cond) (void)__hip_atomic_fetch_or((unsigned*)(P.ws + WS_CTL) + 64, (bitv), __ATOMIC_RELAXED, __HIP_MEMORY_SCOPE_AGENT); } while (0)
__device__ __forceinline__ bool nonfin(float v) { return !(fabsf(v) < 3e38f); }
__device__ __forceinline__ bool nonfin16(const f32x16& v) { bool b = false;
#pragma unroll
    for (int r = 0; r < 16; ++r) b = b || nonfin(v[r]); return b; }
__device__ __forceinline__ bool bfbad(unsigned w) { return ((w & 0x7f80u) == 0x7f80u) || ((w & 0x7f800000u) == 0x7f800000u); }
#else
#define NSA_FLAG(cond, bitv) do { } while (0)
#endif
__device__ __forceinline__ void nsa_unit(const Ptrs& P, Frame& F, int bg, int tt, int nbg, int ntt, bool first, int& cbio) {
    const bf16* proj1 = (const bf16*)(P.ws + WS_BIG);
    const bf16* kcmp = (const bf16*)(P.ws + WS_X2 + 4 * MiB);
    const bf16* vcmp = kcmp + 4096 * 64;
    bf16* ocat = (bf16*)(P.ws + WS_OCAT);
    LAS unsigned char* L = F.lds;
    int lane_ = F.lane, tid_ = F.tid; asm volatile("" : "+v"(lane_), "+v"(tid_));
    const int b = bg >> 1, g = bg & 1, lane = lane_, r32 = lane & 31, hi = lane >> 5, w = F.wave, tid = tid_;
    const int hh = (w < 4) ? w : 11 - w;
    const int t0 = tt * 32, t = t0 + r32, hq = g * 8 + hh;
    const size_t row = (size_t)b * T + t;
    const float sl2 = exp2f(-0.5f * (float)(hh * 2 + g + 1)) * LOG2E;
    bf16x8 qf[4];
#pragma unroll
    for (int d0 = 0; d0 < 4; ++d0) qf[d0] = *(const GAS bf16x8*)(proj1 + row * N1 + hq * 64 + d0 * 16 + hi * 8);
    float qn2 = 0.f;
#pragma unroll
    for (int d0 = 0; d0 < 4; ++d0) { const v4u x = __builtin_bit_cast(v4u, qf[d0]); qn2 += ksq8(x); }
    qn2 = both_sum(qn2) * 1.0001f;
#define NSA_GATE_LD(k_) ({ int go_ = (int)(row * N1) + 1792 + hq * 3 + (k_); asm volatile("" : "+v"(go_)); ((const unsigned short*)proj1)[go_]; })
#define NSA_GATE(raw_) sigmoidf_(__builtin_bit_cast(float, (unsigned)(raw_) << 16))
    LAS float* IMP = (LAS float*)(L + IMP_OFF); LAS float* IMPT = (LAS float*)(L + IMPT_OFF);
    for (int i = tid; i < 32 * IMP_LD; i += NTHR) IMP[i] = 0.f;
    const int vtoff = (4 * hi + ((lane & 15) >> 2)) * V_ROW + (16 * ((lane >> 4) & 1) + 4 * (lane & 3)) * 2;
    const int srow = (tid >> 3) & 31, sch = tid & 7;
    v4u kreg, vreg, kreg2, vreg2;
#ifdef PROBE_KNOB
#define NSA_LOAD(Kg0, Vg0, pitch) do { if (w < 4) { const bf16* Kg = (P.knob & 256) ? proj1 + 1280 : (Kg0); const bf16* Vg = (P.knob & 256) ? proj1 + 1408 : (Vg0); kreg = *(const GAS v4u*)((Kg) + (size_t)srow * (pitch) + sch * 8); vreg = *(const GAS v4u*)((Vg) + (size_t)srow * (pitch) + sch * 8); \
        kreg2 = *(const GAS v4u*)((Kg) + (size_t)(srow + 32) * (pitch) + sch * 8); vreg2 = *(const GAS v4u*)((Vg) + (size_t)(srow + 32) * (pitch) + sch * 8); } } while (0)
#else
#define NSA_LOAD(Kg, Vg, pitch) do { if (w < 4) { kreg = *(const GAS v4u*)((Kg) + (size_t)srow * (pitch) + sch * 8); vreg = *(const GAS v4u*)((Vg) + (size_t)srow * (pitch) + sch * 8); \
        kreg2 = *(const GAS v4u*)((Kg) + (size_t)(srow + 32) * (pitch) + sch * 8); vreg2 = *(const GAS v4u*)((Vg) + (size_t)(srow + 32) * (pitch) + sch * 8); } } while (0)
#endif
#define NSA_WRITE(buf) do { if (w < 4) { LAS unsigned char* kw_ = L + (KB_OFF + srow * 128 + ((sch ^ (srow & 7)) << 4)) + (buf) * KB_SZ; LAS unsigned char* vw_ = L + (VB_OFF + srow * V_ROW + sch * 16) + (buf) * VB_SZ; \
        *(LAS v4u*)kw_ = kreg; *(LAS v4u*)vw_ = vreg; *(LAS v4u*)(kw_ + 32 * 128) = kreg2; *(LAS v4u*)(vw_ + 32 * V_ROW) = vreg2; \
        KNOB_KMX(float ka_ = ksq8(kreg), kb_ = ksq8(kreg2); ka_ = wave_max(fmaxf(sum8(ka_), sum8(kb_))); if (lane == 0) ((LAS float*)(L + KMX_OFF))[(buf) * 4 + w] = ka_;) } } while (0)
#define NSA_SB() __builtin_amdgcn_sched_barrier(0)
#define NSA_KLD(x0_, x1_, d0_) do { const int off_ = (((2 * (d0_) + hi) ^ (r32 & 7)) << 4); x0_ = *(const LAS bf16x8*)(kb_ + off_); x1_ = *(const LAS bf16x8*)(kb_ + 32 * 128 + off_); } while (0)
#define NSA_QK(buf, slm_, cb_) do { const LAS unsigned char* kb_ = L + KB_OFF + (buf) * KB_SZ + r32 * 128; bf16x8 ka0_, ka1_, kb0_, kb1_; \
        NSA_KLD(ka0_, ka1_, 0); NSA_KLD(kb0_, kb1_, 1); NSA_SB(); \
        _Pragma("unroll") for (int r = 0; r < 16; ++r) { const int c_ = (r & 3) + 8 * (r >> 2); p0[r] = fmaf((slm_), (float)c_, (cb_)); p1[r] = fmaf((slm_), (float)(c_ + 32), (cb_)); } \
        NSA_SB(); \
        p0 = __builtin_amdgcn_mfma_f32_32x32x16_bf16(ka0_, qf[0], p0, 0, 0, 0); p1 = __builtin_amdgcn_mfma_f32_32x32x16_bf16(ka1_, qf[0], p1, 0, 0, 0); NSA_KLD(ka0_, ka1_, 2); NSA_SB(); \
        p0 = __builtin_amdgcn_mfma_f32_32x32x16_bf16(kb0_, qf[1], p0, 0, 0, 0); p1 = __builtin_amdgcn_mfma_f32_32x32x16_bf16(kb1_, qf[1], p1, 0, 0, 0); NSA_KLD(kb0_, kb1_, 3); NSA_SB(); \
        p0 = __builtin_amdgcn_mfma_f32_32x32x16_bf16(ka0_, qf[2], p0, 0, 0, 0); p1 = __builtin_amdgcn_mfma_f32_32x32x16_bf16(ka1_, qf[2], p1, 0, 0, 0); NSA_SB(); \
        p0 = __builtin_amdgcn_mfma_f32_32x32x16_bf16(kb0_, qf[3], p0, 0, 0, 0); p1 = __builtin_amdgcn_mfma_f32_32x32x16_bf16(kb1_, qf[3], p1, 0, 0, 0); } while (0)
#define NSA_VTR(p_) __builtin_bit_cast(v2u, __builtin_amdgcn_ds_read_tr16_b64_v4i16((LAS v4i16_t*)(p_)))
#define NSA_VLD(lo_, hi_, k_) do { const LAS unsigned char* vp_ = vb_ + (16 * ((k_) >> 1)) * V_ROW + ((k_) & 1) * 64; lo_ = NSA_VTR(vp_); hi_ = NSA_VTR(vp_ + 8 * V_ROW); } while (0)
#define NSA_PV_PRE(buf) const LAS unsigned char* vb_ = L + VB_OFF + (buf) * VB_SZ + vtoff; v2u vl0_, vh0_, vl1_, vh1_; NSA_VLD(vl0_, vh0_, 0); NSA_VLD(vl1_, vh1_, 1); NSA_SB()
#define NSA_PV_MAIN() do { \
        _Pragma("unroll") for (int g_ = 0; g_ < 4; ++g_) { v4u pw_; \
            if (g_ < 2) { pw_.x = pg8::cvt_pk_bf16(p0[8 * (g_ & 1) + 0], p0[8 * (g_ & 1) + 1]); pw_.y = pg8::cvt_pk_bf16(p0[8 * (g_ & 1) + 2], p0[8 * (g_ & 1) + 3]); pw_.z = pg8::cvt_pk_bf16(p0[8 * (g_ & 1) + 4], p0[8 * (g_ & 1) + 5]); pw_.w = pg8::cvt_pk_bf16(p0[8 * (g_ & 1) + 6], p0[8 * (g_ & 1) + 7]); } \
            else { pw_.x = pg8::cvt_pk_bf16(p1[8 * (g_ & 1) + 0], p1[8 * (g_ & 1) + 1]); pw_.y = pg8::cvt_pk_bf16(p1[8 * (g_ & 1) + 2], p1[8 * (g_ & 1) + 3]); pw_.z = pg8::cvt_pk_bf16(p1[8 * (g_ & 1) + 4], p1[8 * (g_ & 1) + 5]); pw_.w = pg8::cvt_pk_bf16(p1[8 * (g_ & 1) + 6], p1[8 * (g_ & 1) + 7]); } \
            const bf16x8 pf_ = __builtin_bit_cast(bf16x8, pw_); \
            o0 = __builtin_amdgcn_mfma_f32_32x32x16_bf16(__builtin_bit_cast(bf16x8, (v4u){vl0_.x, vl0_.y, vh0_.x, vh0_.y}), pf_, o0, 0, 0, 0); if (g_ < 3) NSA_VLD(vl0_, vh0_, 2 * g_ + 2); NSA_SB(); \
            o1 = __builtin_amdgcn_mfma_f32_32x32x16_bf16(__builtin_bit_cast(bf16x8, (v4u){vl1_.x, vl1_.y, vh1_.x, vh1_.y}), pf_, o1, 0, 0, 0); if (g_ < 3) NSA_VLD(vl1_, vh1_, 2 * g_ + 3); NSA_SB(); } } while (0)
#define NSA_MASK(lim_, lo_) do { \
        _Pragma("unroll") for (int r = 0; r < 16; ++r) { const int c_ = (r & 3) + 8 * (r >> 2); \
            p0[r] = (c_ <= (lim_) && c_ > (lo_)) ? p0[r] : NEGV; p1[r] = (c_ + 32 <= (lim_) && c_ + 32 > (lo_)) ? p1[r] : NEGV; } } while (0)
#define NSA_ROWMAX(mx_) do { float a_ = max3(p0[0], p1[0], p0[1]), b_ = max3(p0[8], p1[8], p0[9]); a_ = max3(a_, p1[1], p0[2]); b_ = max3(b_, p1[9], p0[10]); \
        a_ = max3(a_, p1[2], p0[3]); b_ = max3(b_, p1[10], p0[11]); a_ = max3(a_, p1[3], p0[4]); b_ = max3(b_, p1[11], p0[12]); a_ = max3(a_, p1[4], p0[5]); b_ = max3(b_, p1[12], p0[13]); \
        a_ = max3(a_, p1[5], p0[6]); b_ = max3(b_, p1[13], p0[14]); a_ = max3(a_, p1[6], p0[7]); b_ = max3(b_, p1[14], p0[15]); a_ = max3(a_, p1[7], p1[15]); mx_ = both_max(max3(a_, b_, b_)); } while (0)
#define EREF() ((m_run > -1e29f) ? m_run : 0.f)
#define NSA_ONLINE(WITH_O, mx_) do { const bool val_ = m_run > -1e29f; const bool sh_ = val_ ? ((mx_) > 0.f) : ((mx_) > -1e29f); \
        if (__any(sh_)) { const float dl_ = sh_ ? (mx_) : 0.f; const float alpha_ = val_ ? fast_exp2(-dl_) : 0.f; l_run *= alpha_; m_run = sh_ ? ((val_ ? m_run : 0.f) + dl_) : m_run; \
            _Pragma("unroll") for (int r = 0; r < 16; ++r) { p0[r] -= dl_; p1[r] -= dl_; } \
            if (WITH_O) { _Pragma("unroll") for (int r = 0; r < 16; ++r) { o0[r] *= alpha_; o1[r] *= alpha_; } } } \
        f32x2 ls2_ = (f32x2){0.f, 0.f}; _Pragma("unroll") for (int r = 0; r < 16; r += 2) { p0[r] = fast_exp2(p0[r]); p0[r + 1] = fast_exp2(p0[r + 1]); p1[r] = fast_exp2(p1[r]); p1[r + 1] = fast_exp2(p1[r + 1]); \
            ls2_ += (f32x2){p0[r], p0[r + 1]}; ls2_ += (f32x2){p1[r], p1[r + 1]}; } \
        l_run += ls2_[0] + ls2_[1]; } while (0)
#define NSA_SKIPPABLE(mx_) __all((m_run > -1e29f) ? ((mx_) <= -SKIP) : ((mx_) < -1e29f))
#define NXT(x_) (((x_) == NBUF - 1) ? 0 : (x_) + 1)
#ifdef PROBE_KNOB
#define KNOB_KMX(...) if (!(P.knob & 128)) { __VA_ARGS__ }
#define KNOB_PV(...) if (!(P.knob & 32)) { __VA_ARGS__ }
#define KNOB_EXP(...) if (!(P.knob & 64)) { __VA_ARGS__ }
#else
#define KNOB_PV(...) __VA_ARGS__
#define KNOB_KMX(...) __VA_ARGS__
#define KNOB_EXP(...) __VA_ARGS__
#endif
#define NSA_BOUNDSKIP(buf, slm_, cb_, nov_) ({ const f32x4_t kx_ = *(const LAS f32x4_t*)(L + KMX_OFF + (buf) * 16); const float km_ = fmaxf(fmaxf(kx_[0], kx_[1]), fmaxf(kx_[2], kx_[3])); \
        const float ub_ = __builtin_amdgcn_sqrtf(qn2 * km_) + fmaf((slm_), 63.f, (cb_)) + 0.01f; __all((m_run > -1e29f) ? (ub_ <= -SKIP) : (nov_)); })
    constexpr float SKIP = 30.f;
    f32x16 p0, p1, o0, o1;
    LAS float* OA = (LAS float*)(L + OA_OFF) + tid;
    float m_run, l_run;

    const int nkt = (t0 >> 10) + 1;
    const int cmaxv = (t - 31) >> 4;
    const bf16* kcb = kcmp + (size_t)bg * 512 * 64; const bf16* vcb = vcmp + (size_t)bg * 512 * 64;
    const bf16* ksb = proj1 + (size_t)b * T * N1 + 1280 + g * 64; const bf16* vsb = proj1 + (size_t)b * T * N1 + 1408 + g * 64;
    const bf16* kwb = proj1 + (size_t)b * T * N1 + 1536 + g * 64; const bf16* vwb = proj1 + (size_t)b * T * N1 + 1664 + g * 64;
    const int jhi = t0 >> 6;
    const int cfull = (t0 - 31) >> 4;
    const float slmc = 16.f * sl2;
    int cb = cbio;
    if (first) { cb = 0; NSA_LOAD(kcb + (size_t)(nkt - 1) * 4096, vcb + (size_t)(nkt - 1) * 4096, 64); NSA_WRITE(0); __syncthreads(); }
#ifdef PROBE_KNOB
#define NKT_RUN ((P.knob & 4) ? 0 : nkt)
#else
#define NKT_RUN nkt
#endif
    m_run = NEGV; l_run = 0.f;
    for (int i = NKT_RUN - 1; i >= 0; --i) {
        const int nx = (i > 0) ? i - 1 : nkt - 1;
        NSA_LOAD(kcb + (size_t)nx * 4096, vcb + (size_t)nx * 4096, 64);
        { const float cbv = sl2 * (float)(1024 * i + 31 - t) + slmc * (float)(4 * hi) - EREF();
          if (!NSA_BOUNDSKIP(cb, slmc, cbv, cmaxv < 64 * i)) {
            NSA_QK(cb, slmc, cbv);
            if (64 * i + 63 > cfull) { const int lim = cmaxv - 64 * i - 4 * hi; NSA_MASK(lim, -100000); }
            float mx; NSA_ROWMAX(mx); if (!NSA_SKIPPABLE(mx)) NSA_ONLINE(false, mx); } }
        NSA_WRITE(NXT(cb));
        __syncthreads(); cb = NXT(cb);
    }
    const float ltot = both_sum(l_run); const float adjc = (m_run > -1e29f) ? (-m_run - __builtin_amdgcn_logf(ltot)) : NEGV;
    o0 = f32x16{}; o1 = f32x16{};
    const unsigned short graw0 = NSA_GATE_LD(0);
    for (int i = NKT_RUN - 1; i >= 0; --i) {
        if (i > 0) NSA_LOAD(kcb + (size_t)(i - 1) * 4096, vcb + (size_t)(i - 1) * 4096, 64);
        else NSA_LOAD(ksb + (size_t)jhi * 64 * N1, vsb + (size_t)jhi * 64 * N1, N1);
        const float cbv = sl2 * (float)(1024 * i + 31 - t) + slmc * (float)(4 * hi) + adjc;
        bool skp; { const f32x4_t kx_ = *(const LAS f32x4_t*)(L + KMX_OFF + cb * 16); const float km_ = fmaxf(fmaxf(kx_[0], kx_[1]), fmaxf(kx_[2], kx_[3]));
                    skp = __all(__builtin_amdgcn_sqrtf(qn2 * km_) + fmaf(slmc, 63.f, cbv) + 0.01f <= -SKIP); }
        if (!skp) {
            NSA_QK(cb, slmc, cbv);
            if (64 * i + 63 > cfull) { const int lim = cmaxv - 64 * i - 4 * hi; NSA_MASK(lim, -100000); }
            float mxn; NSA_ROWMAX(mxn); skp = __all(mxn <= -SKIP); }
        LAS float* it_ = IMPT + (w * 32 + r32) * IMPT_LD + hi;
        if (skp) {
#pragma unroll
            for (int q = 0; q < 8; ++q) it_[2 * q] = 0.f;
            if (hi == 0) it_[16] = 0.f;
        } else {
          NSA_PV_PRE(cb);
#pragma unroll
          for (int r = 0; r < 16; ++r) { p0[r] = fast_exp2(p0[r]); p1[r] = fast_exp2(p1[r]); }
          float mainv[2][4], cr[2][4];
#pragma unroll
          for (int rr = 0; rr < 4; ++rr) { mainv[0][rr] = p0[4 * rr] + p0[4 * rr + 1] + p0[4 * rr + 2] + 0.5f * p0[4 * rr + 3]; cr[0][rr] = partner(0.5f * p0[4 * rr + 3]);
                                           mainv[1][rr] = p1[4 * rr] + p1[4 * rr + 1] + p1[4 * rr + 2] + 0.5f * p1[4 * rr + 3]; cr[1][rr] = partner(0.5f * p1[4 * rr + 3]); }
#pragma unroll
          for (int pp = 0; pp < 2; ++pp)
#pragma unroll
              for (int rr = 0; rr < 4; ++rr) { const float prev = (rr > 0) ? cr[pp][rr - 1] : (pp ? cr[0][3] : 0.f); mainv[pp][rr] += hi ? cr[pp][rr] : prev; }
#pragma unroll
          for (int pp = 0; pp < 2; ++pp)
#pragma unroll
              for (int rr = 0; rr < 4; ++rr) it_[8 * pp + 2 * rr] = mainv[pp][rr];
          if (hi == 0) it_[16] = cr[1][3];
          NSA_PV_MAIN();
        }
        NSA_WRITE(NXT(cb));
        __syncthreads(); cb = NXT(cb);
        { const int tok_ = tid >> 4, sl_ = tid & 15; float s_ = 0.f;
#pragma unroll
          for (int hd = 0; hd < 8; ++hd) s_ += IMPT[(hd * 32 + tok_) * IMPT_LD + sl_];
          IMP[tok_ * IMP_LD + 16 * i + sl_] += s_;
          if (tid < 32) { float c_ = 0.f;
#pragma unroll
              for (int hd = 0; hd < 8; ++hd) c_ += IMPT[(hd * 32 + tid) * IMPT_LD + 16];
              IMP[tid * IMP_LD + 16 * (i + 1)] += c_; } }
        __syncthreads();
    }
    { const float gate0 = NSA_GATE(graw0);
#pragma unroll
      for (int r = 0; r < 16; ++r) { OA[r * 512] = gate0 * o0[r]; OA[(16 + r) * 512] = gate0 * o1[r]; } }

    {
        int lane2 = lane; asm volatile("" : "+v"(lane2));
        const int tokq = lane2 >> 4, l16 = lane2 & 15, tokn = w * 4 + tokq, tq = t0 + tokn, cur = tq >> 6;
        unsigned m0 = 0u, m1 = 0u, m2 = 0u, m3 = 0u;
#ifdef PROBE_KNOB
        if (((((t0 + 31) >> 6) + 1) <= 16) || (P.knob & 8)) {
#else
        if ((((t0 + 31) >> 6) + 1) <= 16) {
#endif
            const unsigned long long ml = (1ull << (cur + 1)) - 1ull; m0 = (unsigned)ml; m1 = (unsigned)(ml >> 32);
        } else {
            float v[8]; unsigned selb = 0u;
#pragma unroll
            for (int k = 0; k < 8; ++k) { const int blk = l16 + 16 * k; const float x = IMP[tokn * IMP_LD + blk];
                v[k] = (blk > cur) ? -1.f : ((blk == 0 || blk == cur || blk == cur - 1) ? 1e4f : x); }
            for (int it = 0; it < 16; ++it) {
                float lm = fmaxf(fmaxf(fmaxf(v[0], v[1]), fmaxf(v[2], v[3])), fmaxf(fmaxf(v[4], v[5]), fmaxf(v[6], v[7])));
                lm = fmaxf(lm, NSA_DPP(lm, 0xB1)); lm = fmaxf(lm, NSA_DPP(lm, 0x4E)); lm = fmaxf(lm, NSA_DPP(lm, 0x141)); lm = fmaxf(lm, NSA_DPP(lm, 0x128));
                int cand = 255;
#pragma unroll
                for (int k = 7; k >= 0; --k) cand = (v[k] == lm) ? (l16 + 16 * k) : cand;
#define NSA_DPPI(x, CTRL) __builtin_amdgcn_mov_dpp((x), (CTRL), 0xf, 0xf, true)
                cand = min(cand, NSA_DPPI(cand, 0xB1)); cand = min(cand, NSA_DPPI(cand, 0x4E)); cand = min(cand, NSA_DPPI(cand, 0x141)); cand = min(cand, NSA_DPPI(cand, 0x128));
#pragma unroll
                for (int k = 0; k < 8; ++k) { const bool hit = (l16 + 16 * k) == cand; v[k] = hit ? -2.f : v[k]; selb |= hit ? (1u << k) : 0u; }
            }
            m0 = (((selb >> 0) & 1u) << l16) | (((selb >> 1) & 1u) << (l16 + 16)); m1 = (((selb >> 2) & 1u) << l16) | (((selb >> 3) & 1u) << (l16 + 16));
            m2 = (((selb >> 4) & 1u) << l16) | (((selb >> 5) & 1u) << (l16 + 16)); m3 = (((selb >> 6) & 1u) << l16) | (((selb >> 7) & 1u) << (l16 + 16));
#define NSA_ORROW(x) do { x |= (unsigned)NSA_DPPI((int)x, 0xB1); x |= (unsigned)NSA_DPPI((int)x, 0x4E); x |= (unsigned)NSA_DPPI((int)x, 0x141); x |= (unsigned)NSA_DPPI((int)x, 0x128); } while (0)
            NSA_ORROW(m0); NSA_ORROW(m1); NSA_ORROW(m2); NSA_ORROW(m3);
#undef NSA_ORROW
#undef NSA_DPPI
            const unsigned long long vlo = (cur >= 63) ? ~0ull : ((1ull << (cur + 1)) - 1ull), vhi = (cur >= 64) ? ((cur >= 127) ? ~0ull : ((1ull << (cur - 63)) - 1ull)) : 0ull;
            m0 &= (unsigned)vlo; m1 &= (unsigned)(vlo >> 32); m2 &= (unsigned)vhi; m3 &= (unsigned)(vhi >> 32);
        }
        if (l16 == 0) *(LAS v4u*)(L + SELM_OFF + tokn * 16) = (v4u){m0, m1, m2, m3};
    }
    __syncthreads();
    if (w == 0) {
        unsigned long long ulo = 0ull, uhi = 0ull, alo = ~0ull, ahi = ~0ull;
        for (int q = 0; q < 32; ++q) { const v4u sm = *(const LAS v4u*)(L + SELM_OFF + q * 16); const unsigned long long a = ((unsigned long long)sm.y << 32) | sm.x, c = ((unsigned long long)sm.w << 32) | sm.z;
            ulo |= a; uhi |= c; alo &= a; ahi &= c; }
        LAS int* UL = (LAS int*)(L + UL_OFF); const int nlo = __builtin_popcountll(ulo);
        if ((ulo >> lane) & 1ull) UL[1 + __builtin_amdgcn_mbcnt_hi((unsigned)(ulo >> 32), __builtin_amdgcn_mbcnt_lo((unsigned)ulo, 0u))] = lane;
        if ((uhi >> lane) & 1ull) UL[1 + nlo + __builtin_amdgcn_mbcnt_hi((unsigned)(uhi >> 32), __builtin_amdgcn_mbcnt_lo((unsigned)uhi, 0u))] = 64 + lane;
        if (lane == 0) { UL[0] = nlo + __builtin_popcountll(uhi); *(LAS v4u*)(L + SELM_OFF + 32 * 16) = (v4u){(unsigned)alo, (unsigned)(alo >> 32), (unsigned)ahi, (unsigned)(ahi >> 32)}; }
    }
    __syncthreads();

    {
        const LAS unsigned* SELW = (const LAS unsigned*)(L + SELM_OFF);
#ifdef PROBE_KNOB
        const LAS int* UL = (const LAS int*)(L + UL_OFF); const int nsel = (P.knob & 2) ? 0 : ((P.knob & 16) ? min(__builtin_amdgcn_readfirstlane(UL[0]), 16) : __builtin_amdgcn_readfirstlane(UL[0]));
#else
        const LAS int* UL = (const LAS int*)(L + UL_OFF); const int nsel = __builtin_amdgcn_readfirstlane(UL[0]);
#endif
        m_run = NEGV; l_run = 0.f; o0 = f32x16{}; o1 = f32x16{};
        const unsigned short graw1 = NSA_GATE_LD(1);
        int jn = jhi;
        for (int i = 0; i < nsel; ++i) {
            const int j = jn;
            if (i + 1 < nsel) { jn = __builtin_amdgcn_readfirstlane(UL[nsel - 1 - i]); NSA_LOAD(ksb + (size_t)jn * 64 * N1, vsb + (size_t)jn * 64 * N1, N1); }
            else NSA_LOAD(kwb + (size_t)jhi * 64 * N1, vwb + (size_t)jhi * 64 * N1, N1);
            { const bool mysel = ((SELW[r32 * 4 + (j >> 5)] >> (j & 31)) & 1u) != 0u; const float cbv = mysel ? (sl2 * (float)(64 * j - t + 4 * hi) - EREF()) : NEGV;
              if (!NSA_BOUNDSKIP(cb, sl2, cbv, !mysel)) {
                NSA_QK(cb, sl2, cbv);
                if (j == jhi) { const int lim = t - 64 * j - 4 * hi; NSA_MASK(lim, -100000); }
                float mx; NSA_ROWMAX(mx);
                if (!NSA_SKIPPABLE(mx)) { NSA_PV_PRE(cb); KNOB_EXP(NSA_ONLINE(true, mx);) KNOB_PV(NSA_PV_MAIN();) } } }
            NSA_WRITE(NXT(cb));
            __syncthreads(); cb = NXT(cb);
        }
        const float il = NSA_GATE(graw1) * fast_rcp(both_sum(l_run));
#pragma unroll
        for (int r = 0; r < 16; ++r) { OA[r * 512] += il * o0[r]; OA[(16 + r) * 512] += il * o1[r]; }
    }
    {
#ifdef PROBE_KNOB
        const int jlo = (t0 >= 511) ? ((t0 - 511) >> 6) : 0, nw = (P.knob & 1) ? 0 : jhi - jlo + 1;
#else
        const int jlo = (t0 >= 511) ? ((t0 - 511) >> 6) : 0, nw = jhi - jlo + 1;
#endif
        m_run = NEGV; l_run = 0.f; o0 = f32x16{}; o1 = f32x16{};
        const unsigned short graw2 = NSA_GATE_LD(2);
        for (int i = 0; i < nw; ++i) {
            const int j = jhi - i;
            if (i + 1 < nw) NSA_LOAD(kwb + (size_t)(j - 1) * 64 * N1, vwb + (size_t)(j - 1) * 64 * N1, N1);
            else if (nbg >= 0) { const int nk_ = (ntt * 32) >> 10; NSA_LOAD(kcmp + ((size_t)nbg * 512 + 64 * nk_) * 64, vcmp + ((size_t)nbg * 512 + 64 * nk_) * 64, 64); }
            { const float cbv = sl2 * (float)(64 * j - t + 4 * hi) - EREF();
              if (!NSA_BOUNDSKIP(cb, sl2, cbv, false)) {
                NSA_QK(cb, sl2, cbv);
                if (!((64 * j + 63 <= t0) && (64 * j > t0 + 31 - 512))) { const int lim = t - 64 * j - 4 * hi; NSA_MASK(lim, lim - 512); }
                float mx; NSA_ROWMAX(mx);
                if (!NSA_SKIPPABLE(mx)) { NSA_PV_PRE(cb); KNOB_EXP(NSA_ONLINE(true, mx);) KNOB_PV(NSA_PV_MAIN();) } } }
            if (i + 1 < nw || nbg >= 0) NSA_WRITE(NXT(cb));
            __syncthreads(); cb = NXT(cb);
        }
        const float il = NSA_GATE(graw2) * fast_rcp(both_sum(l_run));
        bf16* op = ocat + row * D + hq * 64 + 4 * hi;
#pragma unroll
        for (int rr = 0; rr < 4; ++rr) { float a[4], c[4];
#pragma unroll
            for (int e = 0; e < 4; ++e) { a[e] = OA[(4 * rr + e) * 512] + il * o0[4 * rr + e]; c[e] = OA[(16 + 4 * rr + e) * 512] + il * o1[4 * rr + e]; }
            *(GAS v2u*)(op + 8 * rr) = (v2u){pg8::cvt_pk_bf16(a[0], a[1]), pg8::cvt_pk_bf16(a[2], a[3])};
            *(GAS v2u*)(op + 32 + 8 * rr) = (v2u){pg8::cvt_pk_bf16(c[0], c[1]), pg8::cvt_pk_bf16(c[2], c[3])}; }
    }
    cbio = cb;
#undef NSA_GATE
#undef NSA_GATE_LD
#undef NSA_LOAD
#undef NSA_WRITE
#undef NSA_QK
#undef NSA_PV_PRE
#undef NSA_PV_MAIN
#undef NSA_VLD
#undef NSA_KLD
#undef NSA_SB
#undef NSA_VTR
#undef NSA_MASK
#undef NSA_ONLINE
#undef NSA_SKIPPABLE
#undef NSA_BOUNDSKIP
#undef EREF
#undef NSA_ROWMAX
#undef NXT
}
}

constexpr int N_PHASES = 20;
__global__ void __launch_bounds__(NTHR, 2) fwd_kernel(Ptrs P) {
    extern __shared__ __attribute__((aligned(16))) unsigned char lds[];
    Frame F;
    F.lds = (LAS unsigned char*)lds;
    F.tid = threadIdx.x; F.lane = F.tid & 63; F.wave = __builtin_amdgcn_readfirstlane(F.tid >> 6);
    F.G = gridDim.x; { const int bx = blockIdx.x; F.vcu = (F.G % 8 == 0) ? (bx % 8) * (F.G / 8) + bx / 8 : bx; }
    unsigned char* ws = P.ws;
    volatile LAS unsigned* MISC = (volatile LAS unsigned*)(F.lds + MISC_OFF);
    for (int u = F.tid; u < (LDS_BYTES - LDSCTL_OFF) / 4; u += NTHR) ((LAS unsigned*)(F.lds + LDSCTL_OFF))[u] = 0u;
    __syncthreads();
#if MK_ONE_LAUNCH
    XcdBarrier bar = xcd_barrier_post((unsigned*)(ws + WS_CTL) + 4096, MISC + 8);
#define GRID_BAR() xcd_barrier(bar)
#else
    (void)MISC;
#define GRID_BAR() do { } while (0)
#endif
#ifndef RES_ALIGN
#define RES_ALIGN true
#endif
    const int lo = P.ph_lo, hi = P.ph_hi;
#ifndef DUP_MASK
#define DUP_MASK 0
#endif
#define NREP(k) (((DUP_MASK >> (k)) & 1) ? 2 : 1)
#if PROBE_A >= 0
#define PROBE_STAMP(k) do { if (blockIdx.x == 0 && threadIdx.x == 0) ((unsigned long long*)(P.ws + WS_CTL + 65536))[(k)] = __builtin_amdgcn_s_memrealtime(); } while (0)
#else
#define PROBE_STAMP(k) do { } while (0)
#endif
#define IN(k) (lo <= (k) && (k) < hi)
#define SEAM(k) do { if (IN(k) && IN((k) + 1)) GRID_BAR(); PROBE_STAMP((k) + 1); { int t_ = threadIdx.x; asm volatile("" : "+v"(t_)); F.tid = t_; F.lane = t_ & 63; } } while (0)
    float* stats = (float*)(ws + WS_STATS);
    bf16* hb = (bf16*)(ws + WS_HB); bf16* hid = (bf16*)(ws + WS_BIG); bf16* ocat = (bf16*)(ws + WS_OCAT);

    PROBE_STAMP(0);
    if (IN(0)) { for (int rep = 0; rep < NREP(0); ++rep) p0_prologue(P, F); }
    SEAM(0);
#ifdef PROBE_KNOB
#define STAGGER() do { if (P.knob & 4096) { const int n_ = (F.vcu & 7) * ((P.knob >> 13) & 7); for (int i_ = 0; i_ < n_; ++i_) __builtin_amdgcn_s_sleep(16); } } while (0)
#else
#define STAGGER() do { const int n_ = (F.vcu & 7) * STAGGER_Q; for (int i_ = 0; i_ < n_; ++i_) __builtin_amdgcn_s_sleep(16); } while (0)
#endif
#ifndef STAGGER_Q
#define STAGGER_Q 0
#endif
#ifdef PROBE_KNOB
#define EPI_KNOB P.knob
#else
#define EPI_KNOB 0
#endif
#ifndef UP_ALIGN
#define UP_ALIGN true
#endif
#define FFN_UP(ph, idx) if (IN(ph)) { STAGGER(); \
        pg8::Gemm g{hb, (const bf16*)(ws + WS_WGU) + (size_t)(idx) * (2 * FF) * D, D, D, 64, (size_t)256 * D, 0, D}; pg8::StaticOrder S; S.init(M, 2 * FF, F.G, (int)blockIdx.x); \
        pg8::EpiUp E{hid, stats, F.lds + RS_OFF}; pg8::gemm_phase<pg8::EpiUp, pg8::StaticOrder, UP_ALIGN>(F.lds + RING_OFF, g, S, E); } SEAM(ph)
#define FFN_DOWN(ph, idx, basep) if (IN(ph)) { STAGGER(); \
        pg8::Gemm g{hid, (const bf16*)(ws + WS_WD) + (size_t)(idx) * D * FF, FF, FF, 64, (size_t)256 * FF, 0, FF}; pg8::StaticOrder S; S.init(M, D, F.G, (int)blockIdx.x); \
        pg8::EpiRes E{hb, stats, 0.5f, EPI_KNOB}; pg8::gemm_phase<pg8::EpiRes, pg8::StaticOrder, RES_ALIGN>(F.lds + RING_OFF, g, S, E); } SEAM(ph)
#define OUT_PROJ(ph, wptr) if (IN(ph)) { STAGGER(); \
        pg8::Gemm g{ocat, (const bf16*)(wptr), D, D, 64, (size_t)256 * D, 0, D}; pg8::StaticOrder S; S.init(M, D, F.G, (int)blockIdx.x); \
        pg8::EpiRes E{hb, stats, 1.0f, EPI_KNOB}; pg8::gemm_phase<pg8::EpiRes, pg8::StaticOrder, RES_ALIGN>(F.lds + RING_OFF, g, S, E); } SEAM(ph)

    FFN_UP(1, 0);
#if DUP_MASK & 2
#undef SEAM
#define SEAM(k) do { } while (0)
    FFN_UP(1, 0);
#undef SEAM
#define SEAM(k) do { if (IN(k) && IN((k) + 1)) GRID_BAR(); PROBE_STAMP((k) + 1); { int t_ = threadIdx.x; asm volatile("" : "+v"(t_)); F.tid = t_; F.lane = t_ & 63; } } while (0)
#endif
    FFN_DOWN(2, 0, P.x);
#if DUP_MASK & 8
    if (IN(3)) {
        pg8::Gemm g{hb, (const bf16*)(ws + WS_W0IN), D, D, 64, (size_t)256 * D, 0, D}; pg8::StaticOrder S; S.init(M, N0, F.G, (int)blockIdx.x);
        pg8::EpiProj E{(bf16*)(ws + WS_BIG), N0, stats, F.lds + RS_OFF}; pg8::gemm_phase<pg8::EpiProj, pg8::StaticOrder>(F.lds + RING_OFF, g, S, E); }
#endif
    if (IN(3)) {
        pg8::Gemm g{hb, (const bf16*)(ws + WS_W0IN), D, D, 64, (size_t)256 * D, 0, D}; pg8::StaticOrder S; S.init(M, N0, F.G, (int)blockIdx.x);
        pg8::EpiProj E{(bf16*)(ws + WS_BIG), N0, stats, F.lds + RS_OFF}; pg8::gemm_phase<pg8::EpiProj, pg8::StaticOrder>(F.lds + RING_OFF, g, S, E); }
    SEAM(3);
    if (IN(4)) {
        { GlaIn cur, nxt; int u = F.vcu; if (u < 2048) gla_g1_load(P, F, u, cur);
          for (; u < 2048; u += F.G) { const bool hn = u + F.G < 2048; if (hn) gla_g1_load(P, F, u + F.G, nxt); gla_g1_unit(P, F, u, cur); if (hn) cur = nxt; } }
        if (F.vcu == 0) { const float* part = (const float*)(ws + WS_MISC); float* bias = (float*)(ws + WS_MISC + 128 * 1024); const int kv = F.tid >> 8, j = F.tid & 255; float s = 0.f;
            for (int ch = 0; ch < 32; ++ch) s += part[(kv * 32 + ch) * 256 + j];
            bias[F.tid] = s; }
    }
    SEAM(4);
    if (IN(5)) { if (F.tid < 256) gla_g2(P, F); else pool_phase(P, F, F.tid - 256, 256); }
    SEAM(5);
    if (IN(6)) { GlaIn cur, nxt; int u = F.vcu; if (u < 2048) gla_g3_load(P, F, u, cur);
        for (; u < 2048; u += F.G) { const bool hn = u + F.G < 2048; if (hn) gla_g3_load(P, F, u + F.G, nxt); gla_g3_unit(P, F, u, cur); if (hn) cur = nxt; } }
    SEAM(6);
#if DUP_MASK & 128
    if (IN(7)) { pg8::Gemm g{ocat, (const bf16*)(ws + WS_W0OUT), D, D, 64, (size_t)256 * D, 0, D}; pg8::StaticOrder S; S.init(M, D, F.G, (int)blockIdx.x);
        pg8::EpiRes E{hb, stats, 0.0f}; pg8::gemm_phase<pg8::EpiRes, pg8::StaticOrder, RES_ALIGN>(F.lds + RING_OFF, g, S, E); }
#endif
    OUT_PROJ(7, ws + WS_W0OUT);
    FFN_UP(8, 1);
#if DUP_MASK & 512
    if (IN(9)) { pg8::Gemm g{hid, (const bf16*)(ws + WS_WD) + (size_t)(1) * D * FF, FF, FF, 64, (size_t)256 * FF, 0, FF}; pg8::StaticOrder S; S.init(M, D, F.G, (int)blockIdx.x);
        pg8::EpiRes E{hb, stats, 0.0f}; pg8::gemm_phase<pg8::EpiRes, pg8::StaticOrder, RES_ALIGN>(F.lds + RING_OFF, g, S, E); }
#endif
    FFN_DOWN(9, 1, P.out);
    FFN_UP(10, 2);
    FFN_DOWN(11, 2, P.out);
    if (IN(12)) {
        pg8::Gemm g{hb, (const bf16*)(ws + WS_W1IN), D, D, 64, (size_t)256 * D, 0, D}; pg8::StaticOrder S; S.init(M, N1, F.G, (int)blockIdx.x);
        pg8::EpiProj E{(bf16*)(ws + WS_BIG), N1, stats, F.lds + RS_OFF}; pg8::gemm_phase<pg8::EpiProj, pg8::StaticOrder>(F.lds + RING_OFF, g, S, E); }
    SEAM(12);
    if (IN(13)) {
        pg8::Gemm g{(const bf16*)(ws + WS_BIG), (const bf16*)(ws + WS_WC1), 256, 16 * N1, N1, 0, 1, 2048}; pg8::CmpOrder S{F.G, (int)blockIdx.x};
        pg8::EpiPart E{(float*)(ws + WS_OCAT)}; pg8::gemm_phase<pg8::EpiPart, pg8::CmpOrder>(F.lds + RING_OFF, g, S, E); }
    SEAM(13);
    if (IN(14)) { for (int rep = 0; rep < NREP(14); ++rep) cmp2_phase(P, F); }
    SEAM(14);
    if (IN(15)) { int cbio = 0;
#ifdef PROBE_KNOB
        if (P.knob & (1 << 20)) { } else if (P.knob & (1 << 21)) { if (F.wave == 4 || F.wave == 5) __builtin_amdgcn_s_setprio(3); else if (F.wave >= 6) __builtin_amdgcn_s_setprio(1); } else
#endif
        if (F.wave >= 4) __builtin_amdgcn_s_setprio(2);
        for (int i = 0; i * F.G + F.vcu < 2048; ++i) { const int u = i * F.G + F.vcu, un = u + F.G;
            nsa::nsa_unit(P, F, u >> 8, ((u & 255) + 32 * (u >> 8)) & 255, (un < 2048) ? (un >> 8) : -1, ((un & 255) + 32 * (un >> 8)) & 255, i == 0, cbio); }
        __builtin_amdgcn_s_setprio(0); }
    SEAM(15);
    OUT_PROJ(16, ws + WS_W1OUT);
    FFN_UP(17, 3);
    FFN_DOWN(18, 3, P.out);
    if (IN(19)) { final_norm_phase(P, F); }
#undef IN
#undef SEAM
}

extern "C" void kernel_launch(void* const* d_in, const int* in_sizes, int n_in, void* d_out, int out_size, void* d_ws, size_t ws_size, hipStream_t stream) {
    static int grid = 0;
    if (grid == 0) {
        if (n_in != 25 || in_sizes[0] != M * D || out_size != M * D || ws_size < WS_END) { fprintf(stderr, "kernel_launch: unexpected shapes (n_in %d, in0 %d, out %d, ws %zu)\n", n_in, n_in > 0 ? in_sizes[0] : -1, out_size, ws_size); grid = -1; return; }
        int dev = 0, cus = 0, per_cu = 0;
        if (hipGetDevice(&dev) != hipSuccess || hipDeviceGetAttribute(&cus, hipDeviceAttributeMultiprocessorCount, dev) != hipSuccess) { grid = -1; return; }
        if (hipFuncSetAttribute((const void*)fwd_kernel, hipFuncAttributeMaxDynamicSharedMemorySize, LDS_BYTES) != hipSuccess) { fprintf(stderr, "kernel_launch: hipFuncSetAttribute failed\n"); grid = -1; return; }
        if (hipOccupancyMaxActiveBlocksPerMultiprocessor(&per_cu, (const void*)fwd_kernel, NTHR, LDS_BYTES) != hipSuccess || per_cu < 1) fprintf(stderr, "kernel_launch: occupancy query reports %d\n", per_cu);
        (void)hipGetLastError();
        grid = cus;
    }
    if (grid < 0) return;
    (void)hipMemsetAsync((char*)d_ws + WS_CTL, 0, CTL_ZERO_BYTES, stream);
    Ptrs p{};
    const float** pp = (const float**)&p;
    for (int i = 0; i < 25; ++i) pp[i] = (const float*)d_in[i];
    p.out = (float*)d_out; p.ws = (unsigned char*)d_ws;
#if MK_ONE_LAUNCH
    p.ph_lo = 0; p.ph_hi = N_PHASES;
    hipLaunchKernelGGL(fwd_kernel, dim3(grid), dim3(NTHR), LDS_BYTES, stream, p);
#ifdef PROBE_KNOB
    for (int r_ = 0; r_ < PROBE_N; ++r_) { (void)hipMemsetAsync((char*)d_ws + WS_CTL, 0, CTL_ZERO_BYTES, stream); p.ph_lo = PROBE_LO; p.ph_hi = PROBE_HI; p.knob = PROBE_KNOB; hipLaunchKernelGGL(fwd_kernel, dim3(grid), dim3(NTHR), LDS_BYTES, stream, p); }
#endif
#else
    for (int ph = 0; ph < N_PHASES; ++ph) { p.ph_lo = ph; p.ph_hi = ph + 1; hipLaunchKernelGGL(fwd_kernel, dim3(grid), dim3(NTHR), LDS_BYTES, stream, p); }
#endif
}
```

```cpp
#include <hip/hip_runtime.h>
#include <cstdio>
#include <cstdint>

#ifndef DIAG
#define DIAG 0
#endif
#ifndef MK_ONE_LAUNCH
#define MK_ONE_LAUNCH 1
#endif

#ifndef PG8_WGM
#define PG8_WGM 8
#endif
namespace pg8 {
#define PG8_LAS __attribute__((address_space(3)))
typedef unsigned short bf16_t;
typedef short bf16x8 __attribute__((ext_vector_type(8)));
typedef float f32x4 __attribute__((ext_vector_type(4)));
typedef unsigned u32x4 __attribute__((ext_vector_type(4)));
constexpr int BM = 256, BK = 64, HALF = 128, HTB = HALF * BK * 2  , STAGE_BYTES = 8 * HTB, NXCD = 8, WGM = PG8_WGM;

__host__ __device__ __forceinline__ int lds_byte(int r, int c) { const int st = (r >> 4) * 2 + (c >> 5), rr = r & 15, cc = c & 31, ob = rr * 64 + cc * 2; return st * 1024 + (ob ^ (((ob >> 9) & 1) << 5)); }
__host__ __device__ __forceinline__ void stage_rc(int b, int& R, int& C) { const int st = b / 1024, sb = b % 1024, swz = sb ^ (((sb >> 9) & 1) << 5); R = (st >> 1) * 16 + swz / 64; C = (st & 1) * 32 + (swz % 64) / 2; }
__host__ __device__ __forceinline__ int perm32(int rho) { const int n = rho >> 4, i = rho & 15; return 8 * (i >> 2) + 4 * n + (i & 3); }

struct Unit { int pm, pn; };
struct Gemm { const bf16_t* A; const bf16_t* Bt; int K; int lda; int akt; size_t atile; int cmp; int ldb;
    __device__ __forceinline__ size_t aoff(int pm) const {
        if (!cmp) return (size_t)pm * atile;
        const int ksl = pm >> 8, kv = (pm >> 4) & 1, b = (pm >> 2) & 3, gg = (pm >> 1) & 1, half = pm & 1;
        return ((size_t)b * 8192 + (size_t)half * 4096) * 2048 + 1024 + kv * 128 + gg * 64 + (size_t)ksl * 4 * 2048; }
    __device__ __forceinline__ size_t boff(const Unit& u) const { return cmp ? ((size_t)u.pn * 256 * ldb + (size_t)(u.pm >> 8) * 256) : (size_t)u.pn * 256 * ldb; }
};

struct StaticOrder {
    int nM, nN, nwg, G, c;
    __host__ __device__ void init(int M, int N, int G_, int c_) { nM = M / BM; nN = N / BM; nwg = nM * nN; G = G_; c = c_; }
    __host__ __device__ bool next(int i, Unit& u) const {
        const long L = (long)i * G + c; if (L >= nwg) return false;
        int wgid = (int)L; { const int q = nwg / NXCD, r = nwg % NXCD, xcd = wgid % NXCD, off = wgid / NXCD; wgid = (xcd < r ? xcd * (q + 1) : r * (q + 1) + (xcd - r) * q) + off; }
        const int nig = WGM * nN, gid = wgid / nig, fm = gid * WGM, gsz = (nM - fm) < WGM ? (nM - fm) : WGM;
        u.pm = fm + ((wgid % nig) % gsz); u.pn = (wgid % nig) / gsz; return true;
    }
};
struct CmpOrder {
    int G, c;
    __device__ __forceinline__ bool next(int i, Unit& u) const { const int L = i * G + c; if (L >= 256) return false; u.pm = (L >> 3) | ((L & 7) << 8); u.pn = L >> 7; return true; }
};

__device__ __forceinline__ unsigned cvt_pk_bf16(float lo, float hi) { unsigned r; asm volatile("v_cvt_pk_bf16_f32 %0, %1, %2" : "=v"(r) : "v"(lo), "v"(hi)); return r; }

template <class Epi, class Sched, bool ALIGN_EPI = true>
__device__ __forceinline__ void gemm_phase(PG8_LAS unsigned char* lds, const Gemm g, const Sched& S, const Epi& E) {
    int tid_ = threadIdx.x; asm volatile("" : "+v"(tid_));
    const int tid = tid_, wid = __builtin_amdgcn_readfirstlane(tid >> 6), lane = tid & 63, wr = wid >> 2, wc = wid & 3, fr = lane & 15, fq = lane >> 4;
    const int K = g.K, nt = K / BK;
    unsigned voffA[2], voffB[2];
#pragma unroll
    for (int i = 0; i < 2; ++i) { int R, C; stage_rc(tid * 16 + i * 8192, R, C); const int Rb = Epi::PERM ? ((R & ~31) + perm32(R & 31)) : R;
        voffA[i] = (unsigned)(R * g.lda + C) * 2u; voffB[i] = (unsigned)(Rb * g.ldb + C) * 2u; }
    const size_t kstepA = (size_t)g.akt * 2, kstepB = (size_t)(BK * 2);
    const size_t hstepA = (size_t)HALF * g.lda * 2, hstepB = (size_t)HALF * g.ldb * 2;
    const unsigned ldsw = (unsigned)wid * 1024u;
    const int aoff = lds_byte(wr * 64 + fr, fq * 8), boff = lds_byte(wc * 32 + fr, fq * 8);
#define PG8_SA(b, h) (((b) * 2 + (h)) * HTB)
#define PG8_SB(b, h) ((4 + (b) * 2 + (h)) * HTB)
#define PG8_STAGE(bufoff, gbase, voff) do { _Pragma("unroll") for (int _i = 0; _i < 2; ++_i) \
        __builtin_amdgcn_global_load_lds((const unsigned*)((const char*)(gbase) + (voff)[_i]), (PG8_LAS unsigned*)(lds + (bufoff) + ldsw + _i * 8192), 16, 0, 0); } while (0)
#define PG8_LDA(dst, b, h) do { _Pragma("unroll") for (int m = 0; m < 4; ++m) _Pragma("unroll") for (int k = 0; k < 2; ++k) dst[m][k] = *(const PG8_LAS bf16x8*)(lds + PG8_SA(b, h) + aoff + m * 2048 + k * 1024); } while (0)
#define PG8_LDB(dst, b, h) do { _Pragma("unroll") for (int n = 0; n < 2; ++n) _Pragma("unroll") for (int k = 0; k < 2; ++k) dst[n][k] = *(const PG8_LAS bf16x8*)(lds + PG8_SB(b, h) + boff + n * 2048 + k * 1024); } while (0)
#define PG8_MMA(ai, bj, At, Bt) do { __builtin_amdgcn_s_setprio(1); _Pragma("unroll") for (int m = 0; m < 4; ++m) _Pragma("unroll") for (int n = 0; n < 2; ++n) _Pragma("unroll") for (int k = 0; k < 2; ++k) \
        acc[ai][bj][m][n] = __builtin_amdgcn_mfma_f32_16x16x32_bf16(Bt[n][k], At[m][k], acc[ai][bj][m][n], 0, 0, 0); __builtin_amdgcn_s_setprio(0); } while (0)
#define PG8_WAIT_V(n) asm volatile("s_waitcnt vmcnt(" #n ")" ::: "memory")
#define PG8_WAIT_L(n) asm volatile("s_waitcnt lgkmcnt(" #n ")" ::: "memory")
#define PG8_BAR __builtin_amdgcn_s_barrier()
#define PG8_SCHED __builtin_amdgcn_sched_barrier(0)
    Unit cur, nxt; int ui = 0;
    if (!S.next(0, cur)) return;
    f32x4 acc[2][2][4][2];
#pragma unroll
    for (int a = 0; a < 2; ++a)
#pragma unroll
        for (int b = 0; b < 2; ++b)
#pragma unroll
            for (int m = 0; m < 4; ++m)
#pragma unroll
                for (int n = 0; n < 2; ++n) acc[a][b][m][n] = (f32x4){0.f, 0.f, 0.f, 0.f};
    bf16x8 At[4][2], B0[2][2], B1[2][2];
    const char* cA = (const char*)g.A + g.aoff(cur.pm) * 2; const char* cB = (const char*)g.Bt + g.boff(cur) * 2;
    if constexpr (Epi::NEEDS_RS) {
        constexpr int MAXU = 12; f32x4 sa[MAXU], sb[MAXU]; bool ok[MAXU];
#pragma unroll
        for (int i = 0; i < MAXU; ++i) { Unit u_; ok[i] = S.next(i, u_); sa[i] = (f32x4){0.f, 0.f, 0.f, 0.f}; sb[i] = sa[i];
            if (ok[i]) { const float* sp_ = E.stats + ((size_t)(u_.pm * BM + (tid >> 1)) * 16 + (tid & 1) * 8); sa[i] = *(const f32x4*)sp_; sb[i] = *(const f32x4*)(sp_ + 4); } }
#pragma unroll
        for (int i = 0; i < MAXU; ++i) if (ok[i]) { float s_ = ((sa[i][0] + sa[i][1]) + (sa[i][2] + sa[i][3])) + ((sb[i][0] + sb[i][1]) + (sb[i][2] + sb[i][3]));
            s_ += __builtin_bit_cast(float, __builtin_amdgcn_mov_dpp(__builtin_bit_cast(int, s_), 0xB1, 0xf, 0xf, true));
            if ((tid & 1) == 0) ((PG8_LAS float*)(E.rs_lds + i * 1024))[tid >> 1] = __builtin_amdgcn_rsqf(s_ * (1.0f / 1024.0f) + 1e-6f); }
    }
    PG8_STAGE(PG8_SB(0, 0), cB, voffB); PG8_STAGE(PG8_SB(0, 1), cB + hstepB, voffB); PG8_STAGE(PG8_SA(0, 0), cA, voffA); PG8_STAGE(PG8_SA(0, 1), cA + hstepA, voffA);
    if (wr == 1) PG8_BAR;
    PG8_WAIT_V(2); PG8_BAR;
    PG8_STAGE(PG8_SB(1, 0), cB + kstepB, voffB); PG8_STAGE(PG8_SA(1, 0), cA + kstepA, voffA); PG8_STAGE(PG8_SB(1, 1), cB + hstepB + kstepB, voffB);
    PG8_WAIT_V(6); PG8_BAR;
    for (;;) {
        const bool has_next = S.next(ui + 1, nxt);
        const char* nA = has_next ? (const char*)g.A + g.aoff(nxt.pm) * 2 : cA; const char* nB = has_next ? (const char*)g.Bt + g.boff(nxt) * 2 : cB;
        for (int t = 0; t < nt; t += 2) {
            const bool last = (t == nt - 2);
            const char* a1 = cA + (size_t)(t + 1) * kstepA;
            const char* a2 = last ? nA : cA + (size_t)(t + 2) * kstepA; const char* b2 = last ? nB : cB + (size_t)(t + 2) * kstepB;
            const char* a3 = a2 + kstepA; const char* b3 = b2 + kstepB;
            PG8_LDB(B0, 0, 0); PG8_LDB(B1, 0, 1); PG8_SCHED; PG8_LDA(At, 0, 0); PG8_STAGE(PG8_SA(1, 1), a1 + hstepA, voffA);
            PG8_WAIT_V(8); PG8_WAIT_L(0); PG8_BAR; PG8_MMA(0, 0, At, B0); PG8_MMA(0, 1, At, B1); PG8_BAR; PG8_SCHED;
            PG8_LDA(At, 0, 1); PG8_STAGE(PG8_SB(0, 0), b2, voffB); PG8_STAGE(PG8_SB(0, 1), b2 + hstepB, voffB); PG8_STAGE(PG8_SA(0, 0), a2, voffA);
            PG8_WAIT_V(8); PG8_WAIT_L(0); PG8_BAR; PG8_MMA(1, 0, At, B0); PG8_MMA(1, 1, At, B1); PG8_BAR; PG8_SCHED;
            PG8_LDB(B0, 1, 0); PG8_LDB(B1, 1, 1); PG8_SCHED; PG8_LDA(At, 1, 0); PG8_STAGE(PG8_SA(0, 1), a2 + hstepA, voffA);
            PG8_WAIT_V(8); PG8_WAIT_L(0); PG8_BAR; PG8_MMA(0, 0, At, B0); PG8_MMA(0, 1, At, B1); PG8_BAR; PG8_SCHED;
            PG8_LDA(At, 1, 1); PG8_STAGE(PG8_SB(1, 0), b3, voffB); PG8_STAGE(PG8_SB(1, 1), b3 + hstepB, voffB); PG8_STAGE(PG8_SA(1, 0), a3, voffA);
            PG8_WAIT_V(8); PG8_WAIT_L(0); PG8_BAR; PG8_MMA(1, 0, At, B0); PG8_MMA(1, 1, At, B1); PG8_BAR; PG8_SCHED;
        }
        if constexpr (ALIGN_EPI) { if (wr == 0) PG8_BAR; }
        E(acc, cur, wr, wc, fr, fq, ui);
        if (!has_next) break;
#pragma unroll
        for (int a = 0; a < 2; ++a)
#pragma unroll
            for (int b = 0; b < 2; ++b)
#pragma unroll
                for (int m = 0; m < 4; ++m)
#pragma unroll
                    for (int n = 0; n < 2; ++n) acc[a][b][m][n] = (f32x4){0.f, 0.f, 0.f, 0.f};
        cur = nxt; cA = nA; cB = nB; ++ui;
        if constexpr (ALIGN_EPI) { if (wr == 1) PG8_BAR; }
    }
    PG8_WAIT_V(0);
    if constexpr (!ALIGN_EPI) { if (wr == 0) PG8_BAR; }
    PG8_BAR;
#undef PG8_SA
#undef PG8_SB
#undef PG8_STAGE
#undef PG8_LDA
#undef PG8_LDB
#undef PG8_MMA
#undef PG8_WAIT_V
#undef PG8_WAIT_L
#undef PG8_BAR
#undef PG8_SCHED
}
}
#ifndef PROBE_A
#define PROBE_A -1
#define PROBE_B -1
#endif

constexpr int NWAVES = 8, NTHR = 512;
constexpr int Bsz = 4, T = 8192, D = 1024, FF = 2816, M = Bsz * T;
constexpr int N0 = 2304;
constexpr int N1 = 2048;
constexpr float EPS = 1e-6f;
constexpr float LOG2E = 1.4426950408889634f;

constexpr size_t MiB = 1u << 20;
constexpr size_t WS_CTL = 0, CTL_ZERO_BYTES = 1 * MiB;
constexpr size_t WS_STATS = 1 * MiB;
constexpr size_t WS_MISC = 3 * MiB;
constexpr size_t WS_WGU = 4 * MiB;
constexpr size_t WS_WD = 48 * MiB;
constexpr size_t WS_W0IN = 70 * MiB;
constexpr size_t WS_W0OUT = 75 * MiB;
constexpr size_t WS_W1IN = 77 * MiB;
constexpr size_t WS_W1OUT = 81 * MiB;
constexpr size_t WS_WC1 = 83 * MiB;
constexpr size_t WS_HB = 86 * MiB;
constexpr size_t WS_BIG = 150 * MiB;
constexpr size_t WS_X2 = 326 * MiB;
constexpr size_t WS_DECAY = 390 * MiB;
constexpr size_t WS_OCAT = 391 * MiB;
constexpr size_t WS_SPT = 456 * MiB;
constexpr size_t WS_END = 488 * MiB;

constexpr int RING_OFF = 0, RING_BYTES = 131072;
constexpr int RS_OFF = RING_BYTES;
constexpr int LDS_BYTES = 147456;
constexpr int LDSCTL_OFF = LDS_BYTES - 1024, MISC_OFF = LDSCTL_OFF + 320;

#define GAS __attribute__((address_space(1)))
#define LAS __attribute__((address_space(3)))
typedef unsigned short bf16;
typedef unsigned v4u __attribute__((ext_vector_type(4)));
typedef unsigned v2u __attribute__((ext_vector_type(2)));
typedef float f32x4 __attribute__((ext_vector_type(4)));
typedef float f32x16 __attribute__((ext_vector_type(16)));
typedef short bf16x8 __attribute__((ext_vector_type(8)));
typedef GAS unsigned gu32;
#define RLX_AGENT __ATOMIC_RELAXED, __HIP_MEMORY_SCOPE_AGENT
#define LDS_WAIT() asm volatile("s_waitcnt lgkmcnt(0)" ::: "memory")
#define VM_WAIT() asm volatile("s_waitcnt vmcnt(0)" ::: "memory")
__device__ __forceinline__ unsigned f2bf(float f) { unsigned u = __builtin_bit_cast(unsigned, f); return (u + 0x7fffu + ((u >> 16) & 1u)) >> 16; }
__device__ __forceinline__ unsigned pk2(float lo, float hi) { return f2bf(lo) | (f2bf(hi) << 16); }
__device__ __forceinline__ float bf2f(unsigned short b) { return __builtin_bit_cast(float, (unsigned)b << 16); }
__device__ __forceinline__ float bflo(unsigned w) { return __builtin_bit_cast(float, w << 16); }
__device__ __forceinline__ float bfhi(unsigned w) { return __builtin_bit_cast(float, w & 0xffff0000u); }
__device__ __forceinline__ float fast_exp2(float x) { return __builtin_amdgcn_exp2f(x); }
__device__ __forceinline__ float fast_rcp(float x) { return __builtin_amdgcn_rcpf(x); }
__device__ __forceinline__ float sigmoidf_(float x) { return fast_rcp(1.0f + fast_exp2(-x * LOG2E)); }
__device__ __forceinline__ float siluf_(float x) { return x * sigmoidf_(x); }
__device__ __forceinline__ float wave_sum(float v) {
#pragma unroll
    for (int o = 1; o < 64; o <<= 1) v += __shfl_xor(v, o);
    return v;
}

namespace pg8 {
typedef float f32x2v __attribute__((ext_vector_type(2)));
__device__ __forceinline__ void row_scales(const PG8_LAS unsigned char* tab, int wr, int fr, float (&rs)[2][4]) {
#pragma unroll
    for (int ai = 0; ai < 2; ++ai)
#pragma unroll
        for (int m = 0; m < 4; ++m) rs[ai][m] = ((const PG8_LAS float*)tab)[ai * HALF + wr * 64 + m * 16 + fr];
}
struct EpiUp {
    static constexpr bool PERM = true, NEEDS_RS = true;
    bf16_t* H; const float* stats; PG8_LAS unsigned char* rs_lds;
    __device__ __forceinline__ void operator()(const f32x4 (&acc)[2][2][4][2], const Unit& u, int wr, int wc, int fr, int fq, int slot) const {
        const int row0 = u.pm * BM + wr * 64 + fr; const PG8_LAS float* tab = (const PG8_LAS float*)(rs_lds + slot * 1024) + wr * 64 + fr;
        const int col0 = u.pn * 128 + wc * 32 + 8 * fq;
#pragma unroll
        for (int ai = 0; ai < 2; ++ai)
#pragma unroll
            for (int m = 0; m < 4; ++m) { const float s = tab[ai * HALF + m * 16]; float o[8];
                const f32x2v sneg = (f32x2v){-s * LOG2E, -s * LOG2E}, s2 = (f32x2v){s * s, s * s}, one = (f32x2v){1.f, 1.f};
#pragma unroll
                for (int n = 0; n < 2; ++n)
#pragma unroll
                    for (int i = 0; i < 4; i += 2) { const f32x2v gv = (f32x2v){acc[ai][0][m][n][i], acc[ai][0][m][n][i + 1]}, uv = (f32x2v){acc[ai][1][m][n][i], acc[ai][1][m][n][i + 1]};
                        const f32x2v tt = gv * sneg; f32x2v e; e.x = fast_exp2(tt.x); e.y = fast_exp2(tt.y); const f32x2v dd = e + one; f32x2v r; r.x = fast_rcp(dd.x); r.y = fast_rcp(dd.y);
                        const f32x2v res = (gv * uv) * (r * s2); o[n * 4 + i] = res.x; o[n * 4 + i + 1] = res.y;
#ifdef EPI_X
                        { const f32x2v t2 = uv * sneg; f32x2v e2; e2.x = fast_exp2(t2.x); e2.y = fast_exp2(t2.y); const f32x2v d2 = e2 + one; f32x2v r2; r2.x = fast_rcp(d2.x); r2.y = fast_rcp(d2.y); const f32x2v q2 = (gv * uv) * (r2 * s2); asm volatile("" :: "v"(q2.x), "v"(q2.y)); }
#endif
                    }
                u32x4 w; w.x = cvt_pk_bf16(o[0], o[1]); w.y = cvt_pk_bf16(o[2], o[3]); w.z = cvt_pk_bf16(o[4], o[5]); w.w = cvt_pk_bf16(o[6], o[7]);
                *(u32x4*)(H + (size_t)(row0 + ai * HALF + m * 16) * FF + col0) = w; }
    }
};
struct EpiRes {
    static constexpr bool PERM = true, NEEDS_RS = false;
    bf16_t* hb; float* stats; float coef; int knob = 0;
    __device__ __forceinline__ void operator()(const f32x4 (&acc)[2][2][4][2], const Unit& u, int wr, int wc, int fr, int fq, int) const {
        if (knob & 65536) return;
        const int row0 = u.pm * BM + wr * 64 + fr, col0 = u.pn * BM + wc * 32 + 8 * fq;
        u32x4 rr[2][4][2];
#pragma unroll
        for (int ai = 0; ai < 2; ++ai)
#pragma unroll
            for (int m = 0; m < 4; ++m)
#pragma unroll
                for (int bj = 0; bj < 2; ++bj) rr[ai][m][bj] = (knob & 131072) ? (u32x4){0u, 0u, 0u, 0u} : *(const u32x4*)(hb + (size_t)(row0 + ai * HALF + m * 16) * D + col0 + bj * HALF);
#pragma unroll
        for (int ai = 0; ai < 2; ++ai)
#pragma unroll
            for (int m = 0; m < 4; ++m) { const int row = row0 + ai * HALF + m * 16; const size_t off = (size_t)row * D + col0; float ss = 0.f;
#pragma unroll
                for (int bj = 0; bj < 2; ++bj) {
                    const u32x4 r = rr[ai][m][bj];
                    const f32x4 r0 = (f32x4){bflo(r.x), bfhi(r.x), bflo(r.y), bfhi(r.y)}, r1 = (f32x4){bflo(r.z), bfhi(r.z), bflo(r.w), bfhi(r.w)};
                    const f32x4 v0 = r0 + acc[ai][bj][m][0] * coef, v1 = r1 + acc[ai][bj][m][1] * coef;
                    u32x4 w; w.x = cvt_pk_bf16(v0[0], v0[1]); w.y = cvt_pk_bf16(v0[2], v0[3]); w.z = cvt_pk_bf16(v1[0], v1[1]); w.w = cvt_pk_bf16(v1[2], v1[3]);
                    if (!(knob & 524288)) *(u32x4*)(hb + off + bj * HALF) = w;
                    ss += (v0[0] * v0[0] + v0[1] * v0[1]) + (v0[2] * v0[2] + v0[3] * v0[3]) + (v1[0] * v1[0] + v1[1] * v1[1]) + (v1[2] * v1[2] + v1[3] * v1[3]); }
                if (!(knob & 262144)) { ss += __shfl_xor(ss, 16); ss += __shfl_xor(ss, 32);
                if (fq == 0) stats[(size_t)row * 16 + u.pn * 4 + wc] = ss; } }
    }
};
struct EpiFinal {
    static constexpr bool PERM = true, NEEDS_RS = false;
    const bf16_t* hb; float* stats; float coef; float* out; const float* gain; unsigned* cnt; PG8_LAS unsigned char* rs_lds;
    __device__ __forceinline__ void operator()(f32x4 (&acc)[2][2][4][2], const Unit& u, int wr, int wc, int fr, int fq, int) const {
        const int row0 = u.pm * BM + wr * 64 + fr, col0 = u.pn * BM + wc * 32 + 8 * fq;
        u32x4 rr[2][4][2];
#pragma unroll
        for (int ai = 0; ai < 2; ++ai)
#pragma unroll
            for (int m = 0; m < 4; ++m)
#pragma unroll
                for (int bj = 0; bj < 2; ++bj) rr[ai][m][bj] = *(const u32x4*)(hb + (size_t)(row0 + ai * HALF + m * 16) * D + col0 + bj * HALF);
#pragma unroll
        for (int ai = 0; ai < 2; ++ai)
#pragma unroll
            for (int m = 0; m < 4; ++m) { const int row = row0 + ai * HALF + m * 16; float ss = 0.f;
#pragma unroll
                for (int bj = 0; bj < 2; ++bj) {
                    const u32x4 r = rr[ai][m][bj];
                    const f32x4 r0 = (f32x4){bflo(r.x), bfhi(r.x), bflo(r.y), bfhi(r.y)}, r1 = (f32x4){bflo(r.z), bfhi(r.z), bflo(r.w), bfhi(r.w)};
                    const f32x4 v0 = r0 + acc[ai][bj][m][0] * coef, v1 = r1 + acc[ai][bj][m][1] * coef;
                    acc[ai][bj][m][0] = v0; acc[ai][bj][m][1] = v1;
                    ss += (v0[0] * v0[0] + v0[1] * v0[1]) + (v0[2] * v0[2] + v0[3] * v0[3]) + (v1[0] * v1[0] + v1[1] * v1[1]) + (v1[2] * v1[2] + v1[3] * v1[3]); }
                ss += __shfl_xor(ss, 16); ss += __shfl_xor(ss, 32);
                if (fq == 0) stats[(size_t)row * 16 + u.pn * 4 + wc] = ss; }
        asm volatile("s_waitcnt vmcnt(0)" ::: "memory");
        __syncthreads();
        if (threadIdx.x == 0) {
            __builtin_amdgcn_fence(__ATOMIC_RELEASE, "agent"); asm volatile("s_waitcnt vmcnt(0)" ::: "memory");
            (void)__hip_atomic_fetch_add(cnt + u.pm, 1u, __ATOMIC_RELAXED, __HIP_MEMORY_SCOPE_AGENT);
            unsigned sp_ = 0u; while (__hip_atomic_load(cnt + u.pm, __ATOMIC_RELAXED, __HIP_MEMORY_SCOPE_AGENT) < 4u && ++sp_ < (1u << 22)) __builtin_amdgcn_s_sleep(1);
            __builtin_amdgcn_fence(__ATOMIC_ACQUIRE, "agent"); asm volatile("s_waitcnt vmcnt(0)" ::: "memory");
        }
        __syncthreads();
        { const int t_ = threadIdx.x;
          if (t_ < 256) { const float* sp = stats + (size_t)(u.pm * BM + t_) * 16;
              const f32x4 a = *(const f32x4*)sp, b = *(const f32x4*)(sp + 4), c = *(const f32x4*)(sp + 8), d = *(const f32x4*)(sp + 12);
              const float s_ = (((a[0] + a[1]) + (a[2] + a[3])) + ((b[0] + b[1]) + (b[2] + b[3]))) + (((c[0] + c[1]) + (c[2] + c[3])) + ((d[0] + d[1]) + (d[2] + d[3])));
              ((PG8_LAS float*)rs_lds)[t_] = __builtin_amdgcn_rsqf(s_ * (1.0f / 1024.0f) + 1e-6f); } }
        __syncthreads();
        const PG8_LAS float* tab = (const PG8_LAS float*)rs_lds + wr * 64 + fr;
        f32x4 gn[2][2];
#pragma unroll
        for (int bj = 0; bj < 2; ++bj) { gn[bj][0] = *(const f32x4*)(gain + col0 + bj * HALF); gn[bj][1] = *(const f32x4*)(gain + col0 + bj * HALF + 4); }
#pragma unroll
        for (int ai = 0; ai < 2; ++ai)
#pragma unroll
            for (int m = 0; m < 4; ++m) { const float s = tab[ai * HALF + m * 16]; float* rowp = out + (size_t)(row0 + ai * HALF + m * 16) * D + col0;
#pragma unroll
                for (int bj = 0; bj < 2; ++bj) { *(f32x4*)(rowp + bj * HALF) = acc[ai][bj][m][0] * s * gn[bj][0]; *(f32x4*)(rowp + bj * HALF + 4) = acc[ai][bj][m][1] * s * gn[bj][1]; } }
        __syncthreads();
    }
};
struct EpiProj {
    static constexpr bool PERM = true, NEEDS_RS = true;
    bf16_t* O; int ldc; const float* stats; PG8_LAS unsigned char* rs_lds;
    __device__ __forceinline__ void operator()(const f32x4 (&acc)[2][2][4][2], const Unit& u, int wr, int wc, int fr, int fq, int slot) const {
        const int row0 = u.pm * BM + wr * 64 + fr; const PG8_LAS float* tab = (const PG8_LAS float*)(rs_lds + slot * 1024) + wr * 64 + fr;
        const int col0 = u.pn * BM + wc * 32 + 8 * fq;
#pragma unroll
        for (int ai = 0; ai < 2; ++ai)
#pragma unroll
            for (int m = 0; m < 4; ++m) { const float s = tab[ai * HALF + m * 16]; bf16_t* rowp = O + (size_t)(row0 + ai * HALF + m * 16) * ldc + col0;
#pragma unroll
                for (int bj = 0; bj < 2; ++bj) { const f32x4 v0 = acc[ai][bj][m][0] * s, v1 = acc[ai][bj][m][1] * s;
                    u32x4 w; w.x = cvt_pk_bf16(v0[0], v0[1]); w.y = cvt_pk_bf16(v0[2], v0[3]); w.z = cvt_pk_bf16(v1[0], v1[1]); w.w = cvt_pk_bf16(v1[2], v1[3]);
                    *(u32x4*)(rowp + bj * HALF) = w; } }
    }
};
__device__ __forceinline__ float gelu_tanh_(float x) { const float y = 1.5957691216057308f * (x + 0.044715f * x * x * x); return x * fast_rcp(1.0f + fast_exp2(-y * LOG2E)); }
struct EpiPart {
    static constexpr bool PERM = true, NEEDS_RS = false;
    bf16_t* part;
    __device__ __forceinline__ void operator()(const f32x4 (&acc)[2][2][4][2], const Unit& u, int wr, int wc, int fr, int fq, int) const {
        const int row0 = (u.pm & 255) * BM + wr * 64 + fr, col0 = wc * 32 + 8 * fq; bf16_t* base = part + (size_t)(u.pm >> 8) * 8192 * 256;
#pragma unroll
        for (int ai = 0; ai < 2; ++ai)
#pragma unroll
            for (int m = 0; m < 4; ++m) { bf16_t* rowp = base + (size_t)(row0 + ai * HALF + m * 16) * 256 + col0;
#pragma unroll
                for (int bj = 0; bj < 2; ++bj) { const f32x4 v0 = acc[ai][bj][m][0], v1 = acc[ai][bj][m][1];
                    u32x4 w; w.x = cvt_pk_bf16(v0[0], v0[1]); w.y = cvt_pk_bf16(v0[2], v0[3]); w.z = cvt_pk_bf16(v1[0], v1[1]); w.w = cvt_pk_bf16(v1[2], v1[3]);
                    *(u32x4*)(rowp + bj * HALF) = w; } }
    }
};
}
#define XB_TMO      128
#define XB_XCNT(j)  (256  + 64 * (j))
#define XB_XSUB(j)  (1280 + 64 * (j))
#define XB_XGEN(j)  (2304 + 64 * (j))
#define XB_TOP      3328
#define XB_TOPGEN   3392
#define XCD_BAR_WORDS 3456
#define XB_SPIN_CAP (1u << 18)

__device__ __forceinline__ unsigned xb_ld(unsigned* p)              { return __hip_atomic_load(p, __ATOMIC_RELAXED, __HIP_MEMORY_SCOPE_AGENT); }
__device__ __forceinline__ unsigned xb_add(unsigned* p, unsigned v) { return __hip_atomic_fetch_add(p, v, __ATOMIC_RELAXED, __HIP_MEMORY_SCOPE_AGENT); }
__device__ __forceinline__ unsigned xb_xcc_id() { return (unsigned)__builtin_amdgcn_s_getreg((3 << 11) | 20) & 0xFu; }
#define XB_SPIN(cond, bar) do { unsigned _sp = 0; while (cond) { __builtin_amdgcn_s_sleep(1); \
    if ((++_sp & 255u) == 0u) { if (xb_ld(&(bar)[XB_TMO])) break; if (_sp > XB_SPIN_CAP) { atomicAdd(&(bar)[XB_TMO], 1u); break; } } } } while (0)

struct XcdBarrier {
    unsigned* bar; unsigned x;
    volatile LAS unsigned* st;
};

__device__ __forceinline__ XcdBarrier xcd_barrier_post(unsigned* bar, volatile LAS unsigned* st) {
    XcdBarrier b; b.bar = bar; b.x = xb_xcc_id(); b.st = st;
    if (threadIdx.x == 0) (void)xb_add(&bar[XB_XCNT(b.x)], 1u);
    return b;
}
__device__ __forceinline__ void xcd_barrier_complete(unsigned* bar, unsigned x, unsigned& nloc, unsigned& nx) {
    const unsigned G = gridDim.x * gridDim.y * gridDim.z;
    unsigned sum, cnt, mine, sp = 0u;
    for (;;) {
        sum = 0u; cnt = 0u; mine = 0u;
#pragma unroll
        for (unsigned j = 0; j < 16; ++j) { const unsigned c = xb_ld(&bar[XB_XCNT(j)]); sum += c; cnt += (c > 0u) ? 1u : 0u; mine = (j == x) ? c : mine; }
        if (sum == G) break;
        __builtin_amdgcn_s_sleep(1);
        if ((++sp & 255u) == 0u) { if (xb_ld(&bar[XB_TMO])) break; if (sp > XB_SPIN_CAP) { atomicAdd(&bar[XB_TMO], 1u); break; } }
    }
    nloc = mine > 0u ? mine : 1u; nx = cnt > 0u ? cnt : 1u;
}

__device__ __forceinline__ void xcd_barrier(const XcdBarrier& b) {
    asm volatile("s_waitcnt vmcnt(0)" ::: "memory");
    __syncthreads();
    if (threadIdx.x == 0) {
        unsigned* bar = b.bar;
        __builtin_amdgcn_s_waitcnt(0);
        unsigned nloc = b.st[0], nx = b.st[1];
        if (nloc == 0u) { xcd_barrier_complete(bar, b.x, nloc, nx); b.st[0] = nloc; b.st[1] = nx; }
        const unsigned old = xb_add(&bar[XB_XSUB(b.x)], 1u);
        const unsigned gen = old / nloc;
        if (old + 1u == (gen + 1u) * nloc) {
            __builtin_amdgcn_fence(__ATOMIC_RELEASE, "agent");
            asm volatile("s_waitcnt vmcnt(0)" ::: "memory");
            const unsigned og = xb_add(&bar[XB_TOP], 1u);
            const unsigned tg = og / nx;
            if (og + 1u == (tg + 1u) * nx) xb_add(&bar[XB_TOPGEN], 1u);
            else XB_SPIN(xb_ld(&bar[XB_TOPGEN]) == tg, bar);
            __builtin_amdgcn_fence(__ATOMIC_ACQUIRE, "agent");
            xb_add(&bar[XB_XGEN(b.x)], 1u);
            asm volatile("s_waitcnt vmcnt(0)" ::: "memory");
        } else {
            XB_SPIN(xb_ld(&bar[XB_XGEN(b.x)]) == gen, bar);
            __builtin_amdgcn_fence(__ATOMIC_ACQUIRE, "agent");
            asm volatile("s_waitcnt vmcnt(0)" ::: "memory");
        }
    }
    __syncthreads();
}

struct Ptrs {
    const float* x; const float* norm_ffn1; const float* ffn1_wg; const float* ffn1_wu; const float* ffn1_wd; const float* norm_mix; const float* norm_ffn2;
    const float* ffn2_wg; const float* ffn2_wu; const float* ffn2_wd; const float* a_w_in; const float* a_gate_w2; const float* a_gate_b; const float* a_gla_norm;
    const float* a_pool_w; const float* a_pool_scale; const float* a_w_out; const float* c_w_in; const float* c_cmp_pe; const float* c_cmpk_w1; const float* c_cmpk_w2;
    const float* c_cmpv_w1; const float* c_cmpv_w2; const float* c_w_out; const float* final_norm;
    float* out; unsigned char* ws; int ph_lo, ph_hi;
#ifdef PROBE_KNOB
    int knob;
#endif
};
struct Frame {
    LAS unsigned char* lds;
    int tid, lane, wave, vcu, G;
};

__device__ __forceinline__ void transpose_item(const float* W, int ldw, int col0, int K, int nvalid, const float* gain, float coef, bf16* WT, int drow0, int mode,
                                               LAS float* scr, int item, int nblk, int lane) {
    const int kb = item / nblk, nb = item % nblk, k0 = 64 * kb, n0 = 32 * nb;
    const int nn = lane & 31; const bool ok = (n0 + nn) < nvalid;
    float v[32];
    const float* src = W + (size_t)(k0 + (lane >> 5)) * ldw + col0 + n0 + (ok ? nn : 0);
#pragma unroll
    for (int i = 0; i < 32; ++i) v[i] = src[(size_t)(2 * i) * ldw];
    if (gain) {
#pragma unroll
        for (int i = 0; i < 32; ++i) v[i] *= gain[k0 + 2 * i + (lane >> 5)];
    }
#pragma unroll
    for (int i = 0; i < 32; ++i) scr[(2 * i + (lane >> 5)) * 33 + nn] = ok ? v[i] * coef : 0.f;
    LDS_WAIT(); asm volatile("" ::: "memory");
    const int c = lane & 7;
    int dbase = drow0 + n0; if (mode == 1) dbase = drow0 + (n0 >> 7) * 256 + (n0 & 127); else if (mode == 2) dbase = drow0 + (n0 >> 7) * 256 + 128 + (n0 & 127);
#pragma unroll
    for (int j = 0; j < 4; ++j) { const int n = (lane >> 3) + 8 * j; const LAS float* s = scr + (8 * c) * 33 + n;
        v4u o; o.x = pk2(s[0 * 33], s[1 * 33]); o.y = pk2(s[2 * 33], s[3 * 33]); o.z = pk2(s[4 * 33], s[5 * 33]); o.w = pk2(s[6 * 33], s[7 * 33]);
        *(GAS v4u*)(WT + (size_t)(dbase + n) * K + k0 + 8 * c) = o; }
    LDS_WAIT(); asm volatile("" ::: "memory");
}
struct TJob { const float* W; int ldw, col0, K, ncols, nvalid; const float* gain; float coef; bf16* WT; int drow0, mode; };
__device__ __forceinline__ void get_job(const Ptrs& P, int id, TJob& j) {
    unsigned char* ws = P.ws;
    j.col0 = 0; j.gain = nullptr; j.coef = 1.f; j.drow0 = 0; j.mode = 0;
    if (id < 8) {
        const int idx = id & 3, l = idx >> 1, f = idx & 1; const bool up = id >= 4;
        j.W = (f == 0 ? (up ? P.ffn1_wu : P.ffn1_wg) : (up ? P.ffn2_wu : P.ffn2_wg)) + (size_t)l * D * FF; j.ldw = FF; j.K = D; j.ncols = FF; j.nvalid = FF;
        j.gain = (f == 0 ? P.norm_ffn1 : P.norm_ffn2) + l * D; j.WT = (bf16*)(ws + WS_WGU) + (size_t)idx * (2 * FF) * D; j.mode = up ? 2 : 1;
    } else if (id < 12) {
        const int idx = id - 8, l = idx >> 1, f = idx & 1;
        j.W = (f == 0 ? P.ffn1_wd : P.ffn2_wd) + (size_t)l * FF * D; j.ldw = D; j.K = FF; j.ncols = D; j.nvalid = D; j.WT = (bf16*)(ws + WS_WD) + (size_t)idx * D * FF;
    } else if (id == 12) {
        j.W = P.a_w_in; j.ldw = 2064; j.K = D; j.ncols = 256; j.nvalid = 256; j.gain = P.norm_mix; j.coef = 0.125f; j.WT = (bf16*)(ws + WS_W0IN);
    } else if (id == 13) {
        j.W = P.a_w_in; j.ldw = 2064; j.col0 = 256; j.K = D; j.ncols = 1280; j.nvalid = 1280; j.gain = P.norm_mix; j.WT = (bf16*)(ws + WS_W0IN); j.drow0 = 256;
    } else if (id == 14) {
        j.W = P.a_w_out; j.ldw = D; j.K = D; j.ncols = D; j.nvalid = D; j.WT = (bf16*)(ws + WS_W0OUT);
    } else if (id == 15) {
        j.W = P.c_w_in; j.ldw = 1840; j.K = D; j.ncols = 1024; j.nvalid = 1024; j.gain = P.norm_mix + D; j.coef = 0.125f * LOG2E; j.WT = (bf16*)(ws + WS_W1IN);
    } else if (id == 16) {
        j.W = P.c_w_in; j.ldw = 1840; j.col0 = 1024; j.K = D; j.ncols = 1024; j.nvalid = 816; j.gain = P.norm_mix + D; j.WT = (bf16*)(ws + WS_W1IN); j.drow0 = 1024;
    } else if (id == 17) {
        j.W = P.c_w_out; j.ldw = D; j.K = D; j.ncols = D; j.nvalid = D; j.WT = (bf16*)(ws + WS_W1OUT);
    } else if (id == 18) {
        j.W = P.c_cmpk_w1; j.ldw = 256; j.K = 2048; j.ncols = 256; j.nvalid = 256; j.WT = (bf16*)(ws + WS_WC1);
    } else {
        j.W = P.c_cmpv_w1; j.ldw = 256; j.K = 2048; j.ncols = 256; j.nvalid = 256; j.WT = (bf16*)(ws + WS_WC1); j.drow0 = 256;
    }
}
constexpr int N_TJOBS = 20;
__host__ __device__ constexpr int p0_job_items(int id) {
    return id < 8 ? (D / 64) * (FF / 32) : id < 12 ? (FF / 64) * (D / 32) : id == 12 ? 16 * 8 : id == 13 ? 16 * 40 : id == 14 ? 16 * 32 : id == 15 ? 16 * 32 : id == 16 ? 16 * 32 : id == 17 ? 16 * 32 : 32 * 8; }
__host__ __device__ constexpr int p0_total_items() { int t = 0; for (int q = 0; q < N_TJOBS; ++q) t += p0_job_items(q); return t; }
constexpr int P0_NITEMS = p0_total_items();


#ifdef PROBE_KNOB
#define P0_KNOB_A ((P.knob & (1 << 22)) != 0)
#define P0_KNOB_E ((P.knob & (1 << 23)) ? M : gw)
#else
#define P0_KNOB_A false
#define P0_KNOB_E gw
#endif
__device__ __forceinline__ void p0_prologue(const Ptrs& P, Frame& F) {
    unsigned char* ws = P.ws;
    LAS float* scr = (LAS float*)(F.lds + RING_OFF + F.wave * 16384);
    const int gw = F.vcu * NWAVES + F.wave, NGW = F.G * NWAVES;
#ifndef P0_DUP
#define P0_DUP 0
#endif
    bf16* W0IN = (bf16*)(ws + WS_W0IN);
    const int rot_ = F.wave % 3;
    for (int st_ = 0; st_ < 3; ++st_) { const int sec_ = (st_ + rot_) % 3;
    if (sec_ == 0) {
    for (int rep = 0; rep < ((P0_DUP & 1) ? 2 : 1); ++rep)
    for (int gi = P0_KNOB_A ? (1 << 30) : gw; gi < P0_NITEMS; gi += NGW) {
        int id = 0, base = 0, cum = 0;
#pragma unroll
        for (int q = 0; q < N_TJOBS - 1; ++q) { cum += p0_job_items(q); if (gi >= cum) { id = q + 1; base = cum; } }
        TJob j; get_job(P, id, j);
        const int nblk = j.ncols / 32;
        transpose_item(j.W, j.ldw, j.col0, j.K, j.nvalid, j.gain, j.coef, j.WT, j.drow0, j.mode, scr, gi - base, nblk, F.lane);
    }
    } else if (sec_ == 1) {
    for (int rep = 0; rep < ((P0_DUP & 2) ? 2 : 1); ++rep) {
    for (int it = gw; it < 256 * 16; it += NGW) {
        const int j = it >> 4, k = (it & 15) * 64 + F.lane; const float* wr = P.a_w_in + (size_t)k * 2064 + 1536; float s = 0.f;
#pragma unroll
        for (int r = 0; r < 16; ++r) s += wr[r] * P.a_gate_w2[r * 256 + j];
        W0IN[(size_t)(1536 + j) * D + k] = (bf16)f2bf(s * P.norm_mix[k]);
    }
    for (int it = gw; it < 512 * 4; it += NGW) {
        const int g = it & 3, k = 2 * (it >> 2) + (F.lane >> 5), d0 = 4 * (F.lane & 31);
        const float* wr = P.a_w_in + (size_t)k * 2064 + 1552 + 128 * g; const float* pw = P.a_pool_w + (size_t)g * 16384 + d0;
        f32x4 s = (f32x4){0.f, 0.f, 0.f, 0.f};
#pragma unroll 4
        for (int c = 0; c < 128; c += 4) { const f32x4 w4 = *(const f32x4*)(wr + c);
            s += w4.x * *(const f32x4*)(pw + (c + 0) * 128); s += w4.y * *(const f32x4*)(pw + (c + 1) * 128); s += w4.z * *(const f32x4*)(pw + (c + 2) * 128); s += w4.w * *(const f32x4*)(pw + (c + 3) * 128); }
        const float gmk = P.norm_mix[k]; const f32x4 ps = *(const f32x4*)(P.a_pool_scale + 128 * g + d0);
#pragma unroll
        for (int e = 0; e < 4; ++e) W0IN[(size_t)(1792 + 128 * g + d0 + e) * D + k] = (bf16)f2bf(s[e] * gmk * ps[e]);
    }
    float* part = (float*)(ws + WS_MISC);
    for (int it = gw; it < 2 * 32 * 4; it += NGW) {
        const int kv = it >> 7, ch = (it >> 2) & 31, j = (it & 3) * 64 + F.lane; const float* w1 = (kv ? P.c_cmpv_w1 : P.c_cmpk_w1) + (size_t)(ch * 64) * 256 + j; const float* pe = P.c_cmp_pe + ch * 64;
        float s = 0.f;
#pragma unroll 32
        for (int k = 0; k < 64; ++k) s += pe[k] * w1[(size_t)k * 256];
        part[(kv * 32 + ch) * 256 + j] = s;
    }
    }
    } else {
    bf16* hb = (bf16*)(ws + WS_HB); float* stats = (float*)(ws + WS_STATS);
    for (int rep = 0; rep < ((P0_DUP & 4) ? 2 : 1); ++rep)
    for (int m = P0_KNOB_E; m < M; m += NGW) {
        const GAS f32x4* xr = (const GAS f32x4*)(P.x + (size_t)m * D) + F.lane; f32x4 v[4]; float s = 0.f;
#pragma unroll
        for (int j = 0; j < 4; ++j) { v[j] = xr[64 * j]; s += (v[j].x * v[j].x + v[j].y * v[j].y) + (v[j].z * v[j].z + v[j].w * v[j].w); }
        s = wave_sum(s);
        GAS unsigned long long* o8 = (GAS unsigned long long*)(hb + (size_t)m * D) + F.lane;
#pragma unroll
        for (int j = 0; j < 4; ++j) o8[64 * j] = (unsigned long long)pk2(v[j].x, v[j].y) | ((unsigned long long)pk2(v[j].z, v[j].w) << 32);
        if (F.lane < 16) stats[(size_t)m * 16 + F.lane] = (F.lane == 0) ? s : 0.f;
    }
    } }
    { v4u* pad = (v4u*)(ws + WS_BIG + (size_t)M * N1 * 2); const int gt = F.vcu * NTHR + F.tid;
      if (gt < 16 * N1 * 2 / 16) pad[gt] = (v4u){0u, 0u, 0u, 0u}; }
}

constexpr int LP = 65;
constexpr int GL_TOT = 63744;
#define GL_BAR() asm volatile("s_waitcnt lgkmcnt(0)\n\ts_barrier" ::: "memory")
struct GlaIn { v4u vv[2], kk, qq; unsigned short zr[8]; float gb; bf16x8 sf[4]; v2u gw[4]; };
__device__ __forceinline__ void gla_load_z(const bf16* proj0, const float* gate_b, int row0, int h, const Frame& F, GlaIn& I) {
    const int d = F.tid & 63, ig = F.tid >> 6; I.gb = gate_b[64 * h + d];
    const unsigned short* zp = (const unsigned short*)(proj0 + (size_t)(row0 + 8 * ig) * N0 + 1536 + 64 * h + d);
#pragma unroll
    for (int r = 0; r < 8; ++r) I.zr[r] = zp[(size_t)r * N0];
}
__device__ __forceinline__ void gla_cumlog(const GlaIn& I, LAS float* LA, const Frame& F) {
    const int d = F.tid & 63, ig = F.tid >> 6; const float gb = I.gb; float pre[8];
#pragma unroll
    for (int r = 0; r < 8; ++r) pre[r] = __builtin_bit_cast(float, (unsigned)I.zr[r] << 16) + gb;
#pragma unroll
    for (int r = 0; r < 8; ++r) { const float zz = pre[r];
        const float e = fast_exp2(-fabsf(zz) * LOG2E); pre[r] = (fminf(zz, 0.f) - __builtin_amdgcn_logf(1.0f + e) * 0.6931471805599453f) * (1.0f / 16.0f); }
#pragma unroll
    for (int r = 1; r < 8; ++r) pre[r] += pre[r - 1];
    LAS float* TOT = (LAS float*)(F.lds + GL_TOT);
    TOT[ig * 64 + d] = pre[7];
    GL_BAR();
    float off = 0.f;
#pragma unroll
    for (int g2 = 0; g2 < 7; ++g2) off += (g2 < ig) ? TOT[g2 * 64 + d] : 0.f;
#pragma unroll
    for (int r = 0; r < 8; ++r) LA[(8 * ig + r) * LP + d] = pre[r] + off;
    GL_BAR();
}
constexpr int GL_VT = 16640, GL_XA = 35072, GL_KI = 44288, GL_ATT = 53504, GL_SS = 62720, GL_LD = 144;
__device__ __forceinline__ void gla_load_v(const bf16* proj0, int row0, int h, const Frame& F, v4u (&vv)[2]) {
    const int i = F.tid >> 3, v0 = (F.tid & 7) * 16;
#pragma unroll
    for (int q = 0; q < 2; ++q) vv[q] = *(const GAS v4u*)(proj0 + (size_t)(row0 + i) * N0 + 512 + 128 * h + v0 + 8 * q);
}
__device__ __forceinline__ void gla_write_vt(const Frame& F, const v4u (&vv)[2]) {
    const int i = F.tid >> 3, v0 = (F.tid & 7) * 16; LAS unsigned short* vt = (LAS unsigned short*)(F.lds + GL_VT) + i;
#pragma unroll
    for (int q = 0; q < 2; ++q) { const unsigned vw[4] = {vv[q].x, vv[q].y, vv[q].z, vv[q].w};
#pragma unroll
        for (int e = 0; e < 8; ++e) vt[(v0 + 8 * q + e) * (GL_LD / 2)] = (unsigned short)((e & 1) ? (vw[e >> 1] >> 16) : (vw[e >> 1] & 0xffffu)); }
}
__device__ __forceinline__ void gla_g1_load(const Ptrs& P, const Frame& F, int unit, GlaIn& I) {
    const bf16* proj0 = (const bf16*)(P.ws + WS_BIG); const int b = unit >> 9, h = (unit >> 7) & 3, n = unit & 127, row0 = b * T + 64 * n;
    gla_load_v(proj0, row0, h, F, I.vv);
    I.kk = *(const GAS v4u*)(proj0 + (size_t)(row0 + (F.tid >> 3)) * N0 + 256 + 64 * h + (F.tid & 7) * 8);
    gla_load_z(proj0, P.a_gate_b, row0, h, F, I);
}
__device__ __forceinline__ void gla_g1_unit(const Ptrs& P, Frame& F, int unit, const GlaIn& I) {
    float* dS = (float*)(P.ws + WS_X2); float* decay = (float*)(P.ws + WS_DECAY);
    LAS float* LA = (LAS float*)(F.lds);
    const v4u kk = I.kk;
    gla_cumlog(I, LA, F);
    { const int i = F.tid >> 3, d0 = (F.tid & 7) * 8;
      const unsigned kw[4] = {kk.x, kk.y, kk.z, kk.w};
      LAS unsigned short* ket = (LAS unsigned short*)(F.lds + GL_XA) + i;
#pragma unroll
      for (int e = 0; e < 8; ++e) { const float kv = (e & 1) ? bfhi(kw[e >> 1]) : bflo(kw[e >> 1]); ket[(d0 + e) * (GL_LD / 2)] = (unsigned short)f2bf(kv * __expf(LA[63 * LP + d0 + e] - LA[i * LP + d0 + e])); }
      gla_write_vt(F, I.vv);
      if (F.tid < 64) decay[(size_t)unit * 64 + F.tid] = __expf(LA[63 * LP + F.tid]); }
    GL_BAR();
    { const int r32 = F.lane & 31, hi = F.lane >> 5, mb = F.wave >> 1, nb = F.wave & 1; f32x16 acc = f32x16{};
      const LAS unsigned char* ap = F.lds + GL_VT + (32 * mb + r32) * GL_LD + 16 * hi; const LAS unsigned char* bp = F.lds + GL_XA + (32 * nb + r32) * GL_LD + 16 * hi;
#pragma unroll
      for (int ks = 0; ks < 4; ++ks) acc = __builtin_amdgcn_mfma_f32_32x32x16_bf16(*(const LAS bf16x8*)(ap + 32 * ks), *(const LAS bf16x8*)(bp + 32 * ks), acc, 0, 0, 0);
      float* op = dS + (size_t)unit * 8192 + (size_t)(32 * mb + 4 * hi) * 64 + 32 * nb + r32;
#pragma unroll
      for (int r = 0; r < 16; ++r) op[((r & 3) + 8 * (r >> 2)) * 64] = acc[r]; }
    GL_BAR();
}
__device__ __forceinline__ void gla_g2(const Ptrs& P, Frame& F) {
    const float* dS = (const float*)(P.ws + WS_X2); const float* decay = (const float*)(P.ws + WS_DECAY); bf16* SPT = (bf16*)(P.ws + WS_SPT);
    for (int e = F.vcu * NTHR + F.tid; e < 16 * 64 * 128; e += F.G * NTHR) {
        const int bh = e >> 13, vd = e & 8191, d = e & 63; float S0 = 0.f, S1 = 0.f;
        for (int n0 = 0; n0 < 128; n0 += 16) { float ds0[16], ds1[16], dc[16];
#pragma unroll
            for (int j = 0; j < 16; ++j) { const size_t u = (size_t)bh * 128 + n0 + j; ds0[j] = dS[u * 8192 + vd]; ds1[j] = dS[u * 8192 + vd + 256]; dc[j] = decay[u * 64 + d]; }
#pragma unroll
            for (int j = 0; j < 16; ++j) { const size_t u = (size_t)bh * 128 + n0 + j; SPT[u * 8192 + vd] = (bf16)f2bf(S0); SPT[u * 8192 + vd + 256] = (bf16)f2bf(S1); S0 = dc[j] * S0 + ds0[j]; S1 = dc[j] * S1 + ds1[j]; } }
    }
}
__device__ __forceinline__ void gla_g3_load(const Ptrs& P, const Frame& F, int unit, GlaIn& I) {
    const bf16* proj0 = (const bf16*)(P.ws + WS_BIG); const bf16* SPT = (const bf16*)(P.ws + WS_SPT);
    const int b = unit >> 9, h = (unit >> 7) & 3, n = unit & 127, row0 = b * T + 64 * n;
    const int r32 = F.lane & 31, hi = F.lane >> 5, ib = F.wave >> 2, vb = F.wave & 3;
#pragma unroll
    for (int ks = 0; ks < 4; ++ks) I.sf[ks] = *(const GAS bf16x8*)(SPT + (size_t)unit * 8192 + (size_t)(32 * vb + r32) * 64 + 16 * ks + 8 * hi);
    gla_load_v(proj0, row0, h, F, I.vv);
    I.qq = *(const GAS v4u*)(proj0 + (size_t)(row0 + (F.tid >> 3)) * N0 + 64 * h + (F.tid & 7) * 8);
    I.kk = *(const GAS v4u*)(proj0 + (size_t)(row0 + (F.tid >> 3)) * N0 + 256 + 64 * h + (F.tid & 7) * 8);
    gla_load_z(proj0, P.a_gate_b, row0, h, F, I);
    const bf16* gp = proj0 + (size_t)(row0 + 32 * ib + r32) * N0 + 1024 + 128 * h + 32 * vb + 4 * hi;
#pragma unroll
    for (int rr = 0; rr < 4; ++rr) I.gw[rr] = *(const GAS v2u*)(gp + 8 * rr);
}
__device__ __forceinline__ void gla_g3_unit(const Ptrs& P, Frame& F, int unit, const GlaIn& I, const f32x4 (&gnr)[4]) {
    bf16* ocat = (bf16*)(P.ws + WS_OCAT);
    const int b = unit >> 9, h = (unit >> 7) & 3, n = unit & 127, row0 = b * T + 64 * n;
    const int r32 = F.lane & 31, hi = F.lane >> 5, ib = F.wave >> 2, vb = F.wave & 3;
    LAS float* LA = (LAS float*)(F.lds);
    const v4u qq = I.qq, kk = I.kk;
    gla_cumlog(I, LA, F);
    { const int i = F.tid >> 3, d0 = (F.tid & 7) * 8;
      const unsigned qw[4] = {qq.x, qq.y, qq.z, qq.w};
      const unsigned kw[4] = {kk.x, kk.y, kk.z, kk.w};
      float qd[8], ki[8];
#pragma unroll
      for (int e = 0; e < 8; ++e) { const float bb = LA[i * LP + d0 + e]; const float qv = (e & 1) ? bfhi(qw[e >> 1]) : bflo(qw[e >> 1]), kv = (e & 1) ? bfhi(kw[e >> 1]) : bflo(kw[e >> 1]);
          qd[e] = qv * __expf(bb); ki[e] = kv * __expf(-bb); }
      *(LAS v4u*)(F.lds + GL_XA + i * GL_LD + d0 * 2) = (v4u){pk2(qd[0], qd[1]), pk2(qd[2], qd[3]), pk2(qd[4], qd[5]), pk2(qd[6], qd[7])};
      *(LAS v4u*)(F.lds + GL_KI + i * GL_LD + d0 * 2) = (v4u){pk2(ki[0], ki[1]), pk2(ki[2], ki[3]), pk2(ki[4], ki[5]), pk2(ki[6], ki[7])};
      gla_write_vt(F, I.vv); }
    GL_BAR();
    f32x16 acc = f32x16{};
    const LAS unsigned char* qp = F.lds + GL_XA + (32 * ib + r32) * GL_LD + 16 * hi;
    if (F.wave == 0 || F.wave == 2 || F.wave == 3) {
        const int jb = (F.wave == 3) ? 1 : 0, ib2 = (F.wave == 0) ? 0 : 1; f32x16 at = f32x16{};
        const LAS unsigned char* kp = F.lds + GL_KI + (32 * jb + r32) * GL_LD + 16 * hi; const LAS unsigned char* qp2 = F.lds + GL_XA + (32 * ib2 + r32) * GL_LD + 16 * hi;
#pragma unroll
        for (int ks = 0; ks < 4; ++ks) at = __builtin_amdgcn_mfma_f32_32x32x16_bf16(*(const LAS bf16x8*)(kp + 32 * ks), *(const LAS bf16x8*)(qp2 + 32 * ks), at, 0, 0, 0);
        const int i = 32 * ib2 + r32;
#pragma unroll
        for (int rr = 0; rr < 4; ++rr) { const int j0 = 32 * jb + 8 * rr + 4 * hi; float a[4];
#pragma unroll
            for (int e = 0; e < 4; ++e) a[e] = (j0 + e <= i) ? at[4 * rr + e] : 0.f;
            *(LAS v2u*)(F.lds + GL_ATT + i * GL_LD + j0 * 2) = (v2u){pk2(a[0], a[1]), pk2(a[2], a[3])}; }
    }
#pragma unroll
    for (int ks = 0; ks < 4; ++ks) acc = __builtin_amdgcn_mfma_f32_32x32x16_bf16(I.sf[ks], *(const LAS bf16x8*)(qp + 32 * ks), acc, 0, 0, 0);
    GL_BAR();
    { const LAS unsigned char* vp = F.lds + GL_VT + (32 * vb + r32) * GL_LD + 16 * hi; const LAS unsigned char* ap = F.lds + GL_ATT + (32 * ib + r32) * GL_LD + 16 * hi;
#pragma unroll
      for (int ks = 0; ks < 4; ++ks) if (ks < 2 || ib == 1) acc = __builtin_amdgcn_mfma_f32_32x32x16_bf16(*(const LAS bf16x8*)(vp + 32 * ks), *(const LAS bf16x8*)(ap + 32 * ks), acc, 0, 0, 0); }
    { float ssq = 0.f;
#pragma unroll
      for (int r = 0; r < 16; ++r) ssq += acc[r] * acc[r];
      ssq += __shfl_xor(ssq, 32);
      LAS float* SS = (LAS float*)(F.lds + GL_SS); const int i = 32 * ib + r32;
      if (hi == 0) SS[vb * 64 + i] = ssq;
      GL_BAR();
      const float tot = (SS[i] + SS[64 + i]) + (SS[128 + i] + SS[192 + i]); const float rs = __builtin_amdgcn_rsqf(tot * (1.0f / 128.0f) + EPS);
      bf16* op = ocat + (size_t)(row0 + i) * D + 128 * h + 32 * vb + 4 * hi;
#pragma unroll
      for (int rr = 0; rr < 4; ++rr) { const v2u gw = I.gw[rr]; const f32x4 nn = gnr[rr];
          const float o0 = acc[4 * rr] * rs * nn[0] * siluf_(bflo(gw.x)), o1 = acc[4 * rr + 1] * rs * nn[1] * siluf_(bfhi(gw.x)), o2 = acc[4 * rr + 2] * rs * nn[2] * siluf_(bflo(gw.y)), o3 = acc[4 * rr + 3] * rs * nn[3] * siluf_(bfhi(gw.y));
          *(GAS v2u*)(op + 8 * rr) = (v2u){pk2(o0, o1), pk2(o2, o3)}; } }
    GL_BAR();
}
__device__ __forceinline__ void pool_phase(const Ptrs& P, Frame& F, int pt, int npt) {
    const bf16* proj0 = (const bf16*)(P.ws + WS_BIG); bf16* ocat = (bf16*)(P.ws + WS_OCAT);
    for (int it = F.vcu * npt + pt; it < (M / 16) * 64; it += F.G * npt) {
        const int seg = it >> 6, ch = it & 63, r0 = seg * 16, t0 = r0 & (T - 1), w = 2 << (ch >> 4);
        const bf16* src = proj0 + (size_t)r0 * N0 + 1792 + ch * 8; bf16* dst = ocat + (size_t)r0 * D + 512 + ch * 8;
        float sum[8];
#pragma unroll
        for (int e = 0; e < 8; ++e) sum[e] = 0.f;
        for (int q = 1; q < w; ++q) if (t0 - q >= 0) { const v4u pv = *(const GAS v4u*)(src - (size_t)q * N0); const unsigned pw[4] = {pv.x, pv.y, pv.z, pv.w};
#pragma unroll
            for (int e = 0; e < 8; ++e) sum[e] += (e & 1) ? bfhi(pw[e >> 1]) : bflo(pw[e >> 1]); }
#pragma unroll 4
        for (int i = 0; i < 16; ++i) { const int t = t0 + i; const int cnt = (t + 1 < w) ? t + 1 : w;
            const v4u pv = *(const GAS v4u*)(src + (size_t)i * N0); const unsigned pw[4] = {pv.x, pv.y, pv.z, pv.w}; float x[8];
#pragma unroll
            for (int e = 0; e < 8; ++e) { x[e] = (e & 1) ? bfhi(pw[e >> 1]) : bflo(pw[e >> 1]); sum[e] += x[e]; }
            const float inv = 1.0f / (float)cnt; v4u o;
            o.x = pk2(sum[0] * inv - x[0], sum[1] * inv - x[1]); o.y = pk2(sum[2] * inv - x[2], sum[3] * inv - x[3]);
            o.z = pk2(sum[4] * inv - x[4], sum[5] * inv - x[5]); o.w = pk2(sum[6] * inv - x[6], sum[7] * inv - x[7]);
            *(GAS v4u*)(dst + (size_t)i * D) = o;
            if (t - w + 1 >= 0) { const v4u qv = *(const GAS v4u*)(src + (size_t)(i - w + 1) * N0); const unsigned qw[4] = {qv.x, qv.y, qv.z, qv.w};
#pragma unroll
                for (int e = 0; e < 8; ++e) sum[e] -= (e & 1) ? bfhi(qw[e >> 1]) : bflo(qw[e >> 1]); } }
    }
}
__device__ __forceinline__ void cmp2_pair(const Ptrs& P, Frame& F, int kv, int row, int rowB, bool hasB) {
    const bf16* part = (const bf16*)(P.ws + WS_OCAT); const float* bias = (const float*)(P.ws + WS_MISC + 128 * 1024); bf16* kc = (bf16*)(P.ws + WS_X2 + 4 * MiB);
    LAS float* hs = (LAS float*)(F.lds) + F.wave * 512;
    f32x4 a = *(const f32x4*)(bias + kv * 256 + 4 * F.lane), b = a;
#pragma unroll
    for (int sl = 0; sl < 8; ++sl) { const v2u p_ = *(const GAS v2u*)(part + ((size_t)sl * 8192 + row) * 256 + 4 * F.lane); a += (f32x4){bflo(p_.x), bfhi(p_.x), bflo(p_.y), bfhi(p_.y)}; }
    if (hasB) {
#pragma unroll
        for (int sl = 0; sl < 8; ++sl) { const v2u p_ = *(const GAS v2u*)(part + ((size_t)sl * 8192 + rowB) * 256 + 4 * F.lane); b += (f32x4){bflo(p_.x), bfhi(p_.x), bflo(p_.y), bfhi(p_.y)}; } }
    *(LAS f32x4*)(hs + 4 * F.lane) = (f32x4){pg8::gelu_tanh_(a[0]), pg8::gelu_tanh_(a[1]), pg8::gelu_tanh_(a[2]), pg8::gelu_tanh_(a[3])};
    *(LAS f32x4*)(hs + 256 + 4 * F.lane) = (f32x4){pg8::gelu_tanh_(b[0]), pg8::gelu_tanh_(b[1]), pg8::gelu_tanh_(b[2]), pg8::gelu_tanh_(b[3])};
    LDS_WAIT(); asm volatile("" ::: "memory");
    const float* w2 = (kv ? P.c_cmpv_w2 : P.c_cmpk_w2) + F.lane; float s0 = 0.f, s1 = 0.f;
#pragma unroll 8
    for (int j = 0; j < 256; j += 4) { const f32x4 h0 = *(const LAS f32x4*)(hs + j), h1 = *(const LAS f32x4*)(hs + 256 + j);
        const float w0 = w2[(j + 0) * 64], w1 = w2[(j + 1) * 64], w2_ = w2[(j + 2) * 64], w3 = w2[(j + 3) * 64];
        s0 += h0[0] * w0 + h0[1] * w1 + h0[2] * w2_ + h0[3] * w3; s1 += h1[0] * w0 + h1[1] * w1 + h1[2] * w2_ + h1[3] * w3; }
    if ((row & 511) == 511) s0 = 0.f;
    kc[(size_t)row * 64 + F.lane] = (bf16)f2bf(s0);
    if (hasB) { if ((rowB & 511) == 511) s1 = 0.f; kc[(size_t)rowB * 64 + F.lane] = (bf16)f2bf(s1); }
    LDS_WAIT(); asm volatile("" ::: "memory");
}
__device__ __forceinline__ void cmp2_phase(const Ptrs& P, Frame& F) {
    const int gw = F.vcu * NWAVES + F.wave, NGW = F.G * NWAVES;
    for (int kv = 0; kv < 2; ++kv)
    for (int row = kv * 4096 + gw; row < (kv + 1) * 4096; row += 2 * NGW) { const int rowB = row + NGW; cmp2_pair(P, F, kv, row, rowB, rowB < (kv + 1) * 4096); }
}
__device__ __forceinline__ void cmp2_fused(const Ptrs& P, Frame& F, int tile, int slice) {
    unsigned* cnt = (unsigned*)(P.ws + WS_CTL + 135168) + tile;
    if (F.tid == 0) {
        __builtin_amdgcn_fence(__ATOMIC_RELEASE, "agent"); asm volatile("s_waitcnt vmcnt(0)" ::: "memory");
        (void)__hip_atomic_fetch_add(cnt, 1u, __ATOMIC_RELAXED, __HIP_MEMORY_SCOPE_AGENT);
        unsigned sp_ = 0u; while (__hip_atomic_load(cnt, __ATOMIC_RELAXED, __HIP_MEMORY_SCOPE_AGENT) < 8u && ++sp_ < (1u << 22)) __builtin_amdgcn_s_sleep(1);
        __builtin_amdgcn_fence(__ATOMIC_ACQUIRE, "agent"); asm volatile("s_waitcnt vmcnt(0)" ::: "memory");
    }
    __syncthreads();
    const int r0 = tile * 256 + slice * 32 + F.wave * 4, kv = r0 >> 12;
    cmp2_pair(P, F, kv, r0, r0 + 1, true); cmp2_pair(P, F, kv, r0 + 2, r0 + 3, true);
}
__device__ __forceinline__ void final_norm_phase(const Ptrs& P, Frame& F) {
    const float* stats = (const float*)(P.ws + WS_STATS); const bf16* hb = (const bf16*)(P.ws + WS_HB); const int gw = F.vcu * NWAVES + F.wave, NGW = F.G * NWAVES;
#if PROBE_A >= 0
    const unsigned long long* TS = (const unsigned long long*)(P.ws + WS_CTL + 65536);
    const float probe_scale = 1.0f + sqrtf((float)(TS[PROBE_B] - TS[PROBE_A]) / (float)(TS[19] - TS[0]));
#else
    const float probe_scale = 1.0f;
#endif
    for (int m = gw; m < M; m += NGW) {
        float s = (F.lane < 16) ? stats[(size_t)m * 16 + F.lane] : 0.f; s = wave_sum(s); const float rs = __builtin_amdgcn_rsqf(s * (1.0f / 1024.0f) + EPS) * probe_scale;
        const GAS v4u* hr = (const GAS v4u*)(hb + (size_t)m * D) + 2 * F.lane; GAS f32x4* xr = (GAS f32x4*)(P.out + (size_t)m * D) + 4 * F.lane; const GAS f32x4* gn = (const GAS f32x4*)P.final_norm + 4 * F.lane;
#pragma unroll
        for (int j = 0; j < 2; ++j) { const v4u h = hr[j];
            xr[2 * j] = (f32x4){bflo(h.x), bfhi(h.x), bflo(h.y), bfhi(h.y)} * rs * gn[2 * j]; xr[2 * j + 1] = (f32x4){bflo(h.z), bfhi(h.z), bflo(h.w), bfhi(h.w)} * rs * gn[2 * j + 1]; }
    }
}

namespace nsa {
typedef float f32x2 __attribute__((ext_vector_type(2)));
typedef short v4i16_t __attribute__((ext_vector_type(4)));
typedef float f32x4_t __attribute__((ext_vector_type(4)));
constexpr int NBUF = 2, KB_OFF = 0, KB_SZ = 8192, VB_OFF = NBUF * KB_SZ, V_ROW = 192, VB_SZ = 64 * V_ROW;
constexpr int IMP_OFF = VB_OFF + NBUF * VB_SZ;
constexpr int IMP_LD = 132;
constexpr int IMPT_OFF = IMP_OFF + 32 * IMP_LD * 4;
constexpr int IMPT_LD = 17;
constexpr int SELM_OFF = IMPT_OFF + 8 * 32 * IMPT_LD * 4;
constexpr int UL_OFF = SELM_OFF + 512 + 64;
constexpr int KMX_OFF = UL_OFF + 528;
constexpr int OA_OFF = UL_OFF + 576;
static_assert(OA_OFF + 32 * 512 * 4 <= LDSCTL_OFF, "NSA LDS map");
constexpr float NEGV = -1e30f;

#define NSA_DPP(x, CTRL) __builtin_bit_cast(float, __builtin_amdgcn_mov_dpp(__builtin_bit_cast(int, (x)), (CTRL), 0xf, 0xf, true))
__device__ __forceinline__ float sum8(float v) { v += NSA_DPP(v, 0xB1); v += NSA_DPP(v, 0x4E); v += NSA_DPP(v, 0x141); return v; }
typedef __bf16 bf16x2_t __attribute__((ext_vector_type(2)));
__device__ __forceinline__ float ksq8(const v4u& x) {
    const bf16x2_t a = __builtin_bit_cast(bf16x2_t, x.x), b = __builtin_bit_cast(bf16x2_t, x.y), c = __builtin_bit_cast(bf16x2_t, x.z), d = __builtin_bit_cast(bf16x2_t, x.w);
    return __builtin_amdgcn_fdot2_f32_bf16(d, d, __builtin_amdgcn_fdot2_f32_bf16(c, c, __builtin_amdgcn_fdot2_f32_bf16(b, b, __builtin_amdgcn_fdot2_f32_bf16(a, a, 0.f, false), false), false), false); }
__device__ __forceinline__ float max3(float a, float b, float c) { float r; asm("v_max3_f32 %0, %1, %2, %3" : "=v"(r) : "v"(a), "v"(b), "v"(c)); return r; }
__device__ __forceinline__ float wave_max(float v) {
    v = fmaxf(v, NSA_DPP(v, 0xB1)); v = fmaxf(v, NSA_DPP(v, 0x4E)); v = fmaxf(v, NSA_DPP(v, 0x141)); v = fmaxf(v, NSA_DPP(v, 0x128));
    const float a = __builtin_bit_cast(float, __builtin_amdgcn_readlane(__builtin_bit_cast(int, v), 0)), b = __builtin_bit_cast(float, __builtin_amdgcn_readlane(__builtin_bit_cast(int, v), 16));
    const float c = __builtin_bit_cast(float, __builtin_amdgcn_readlane(__builtin_bit_cast(int, v), 32)), d = __builtin_bit_cast(float, __builtin_amdgcn_readlane(__builtin_bit_cast(int, v), 48));
    return fmaxf(fmaxf(a, b), fmaxf(c, d));
}
__device__ __forceinline__ void swap32(float v, float& a, float& b) {
    a = v; b = v;
    asm volatile("s_nop 1\n\tv_permlane32_swap_b32 %0, %1\n\ts_nop 1" : "+v"(a), "+v"(b));
}
__device__ __forceinline__ float partner(float v) { float a, b; swap32(v, a, b); return (threadIdx.x & 32) ? a : b; }
__device__ __forceinline__ float both_max(float v) { float a, b; swap32(v, a, b); return fmaxf(a, b); }
__device__ __forceinline__ float both_sum(float v) { float a, b; swap32(v, a, b); return a + b; }

#if DIAG
#define NSA_FLAG(cond, bitv) do { if (cond) (void)__hip_atomic_fetch_or((unsigned*)(P.ws + WS_CTL) + 64, (bitv), __ATOMIC_RELAXED, __HIP_MEMORY_SCOPE_AGENT); } while (0)
__device__ __forceinline__ bool nonfin(float v) { return !(fabsf(v) < 3e38f); }
__device__ __forceinline__ bool nonfin16(const f32x16& v) { bool b = false;
#pragma unroll
    for (int r = 0; r < 16; ++r) b = b || nonfin(v[r]); return b; }
__device__ __forceinline__ bool bfbad(unsigned w) { return ((w & 0x7f80u) == 0x7f80u) || ((w & 0x7f800000u) == 0x7f800000u); }
#else
#define NSA_FLAG(cond, bitv) do { } while (0)
#endif
__device__ __forceinline__ void nsa_unit(const Ptrs& P, Frame& F, int bg, int tt, int nbg, int ntt, bool first, int& cbio) {
    const bf16* proj1 = (const bf16*)(P.ws + WS_BIG);
    const bf16* kcmp = (const bf16*)(P.ws + WS_X2 + 4 * MiB);
    const bf16* vcmp = kcmp + 4096 * 64;
    bf16* ocat = (bf16*)(P.ws + WS_OCAT);
    LAS unsigned char* L = F.lds;
    int lane_ = F.lane, tid_ = F.tid; asm volatile("" : "+v"(lane_), "+v"(tid_));
    const int b = bg >> 1, g = bg & 1, lane = lane_, r32 = lane & 31, hi = lane >> 5, w = F.wave, tid = tid_;
    const int hh = (w < 4) ? w : 11 - w;
    const int t0 = tt * 32, t = t0 + r32, hq = g * 8 + hh;
    const size_t row = (size_t)b * T + t;
    const float sl2 = exp2f(-0.5f * (float)(hh * 2 + g + 1)) * LOG2E;
    bf16x8 qf[4];
#pragma unroll
    for (int d0 = 0; d0 < 4; ++d0) qf[d0] = *(const GAS bf16x8*)(proj1 + row * N1 + hq * 64 + d0 * 16 + hi * 8);
    float qn2 = 0.f;
#pragma unroll
    for (int d0 = 0; d0 < 4; ++d0) { const v4u x = __builtin_bit_cast(v4u, qf[d0]); qn2 += ksq8(x); }
    qn2 = both_sum(qn2) * 1.0001f;
#define NSA_GATE_LD(k_) ({ int go_ = (int)(row * N1) + 1792 + hq * 3 + (k_); asm volatile("" : "+v"(go_)); ((const unsigned short*)proj1)[go_]; })
#define NSA_GATE(raw_) sigmoidf_(__builtin_bit_cast(float, (unsigned)(raw_) << 16))
    LAS float* IMP = (LAS float*)(L + IMP_OFF); LAS float* IMPT = (LAS float*)(L + IMPT_OFF);
    for (int i = tid; i < 32 * IMP_LD; i += NTHR) IMP[i] = 0.f;
    const int vtoff = (4 * hi + ((lane & 15) >> 2)) * V_ROW + (16 * ((lane >> 4) & 1) + 4 * (lane & 3)) * 2;
    const int srow = (tid >> 3) & 31, sch = tid & 7;
    v4u kreg, vreg, kreg2, vreg2;
#ifdef PROBE_KNOB
#define NSA_LOAD(Kg0, Vg0, pitch) do { if (w < 4) { const bf16* Kg = (P.knob & 256) ? proj1 + 1280 : (Kg0); const bf16* Vg = (P.knob & 256) ? proj1 + 1408 : (Vg0); kreg = *(const GAS v4u*)((Kg) + (size_t)srow * (pitch) + sch * 8); vreg = *(const GAS v4u*)((Vg) + (size_t)srow * (pitch) + sch * 8); \
        kreg2 = *(const GAS v4u*)((Kg) + (size_t)(srow + 32) * (pitch) + sch * 8); vreg2 = *(const GAS v4u*)((Vg) + (size_t)(srow + 32) * (pitch) + sch * 8); } } while (0)
#else
#define NSA_LOAD(Kg, Vg, pitch) do { if (w < 4) { kreg = *(const GAS v4u*)((Kg) + (size_t)srow * (pitch) + sch * 8); vreg = *(const GAS v4u*)((Vg) + (size_t)srow * (pitch) + sch * 8); \
        kreg2 = *(const GAS v4u*)((Kg) + (size_t)(srow + 32) * (pitch) + sch * 8); vreg2 = *(const GAS v4u*)((Vg) + (size_t)(srow + 32) * (pitch) + sch * 8); } } while (0)
#endif
#define NSA_WRITE(buf) do { if (w < 4) { LAS unsigned char* kw_ = L + (KB_OFF + srow * 128 + ((sch ^ (srow & 7)) << 4)) + (buf) * KB_SZ; LAS unsigned char* vw_ = L + (VB_OFF + srow * V_ROW + sch * 16) + (buf) * VB_SZ; \
        *(LAS v4u*)kw_ = kreg; *(LAS v4u*)vw_ = vreg; *(LAS v4u*)(kw_ + 32 * 128) = kreg2; *(LAS v4u*)(vw_ + 32 * V_ROW) = vreg2; \
        KNOB_KMX(float ka_ = ksq8(kreg), kb_ = ksq8(kreg2); ka_ = wave_max(fmaxf(sum8(ka_), sum8(kb_))); if (lane == 0) ((LAS float*)(L + KMX_OFF))[(buf) * 4 + w] = ka_;) } } while (0)
#define NSA_SB() __builtin_amdgcn_sched_barrier(0)
#define NSA_KLD(x0_, x1_, d0_) do { const int off_ = (((2 * (d0_) + hi) ^ (r32 & 7)) << 4); x0_ = *(const LAS bf16x8*)(kb_ + off_); x1_ = *(const LAS bf16x8*)(kb_ + 32 * 128 + off_); } while (0)
#define NSA_QK(buf, slm_, cb_) do { const LAS unsigned char* kb_ = L + KB_OFF + (buf) * KB_SZ + r32 * 128; bf16x8 ka0_, ka1_, kb0_, kb1_; \
        NSA_KLD(ka0_, ka1_, 0); NSA_KLD(kb0_, kb1_, 1); NSA_SB(); \
        _Pragma("unroll") for (int r = 0; r < 16; ++r) { const int c_ = (r & 3) + 8 * (r >> 2); p0[r] = fmaf((slm_), (float)c_, (cb_)); p1[r] = fmaf((slm_), (float)(c_ + 32), (cb_)); } \
        NSA_SB(); \
        p0 = __builtin_amdgcn_mfma_f32_32x32x16_bf16(ka0_, qf[0], p0, 0, 0, 0); p1 = __builtin_amdgcn_mfma_f32_32x32x16_bf16(ka1_, qf[0], p1, 0, 0, 0); NSA_KLD(ka0_, ka1_, 2); NSA_SB(); \
        p0 = __builtin_amdgcn_mfma_f32_32x32x16_bf16(kb0_, qf[1], p0, 0, 0, 0); p1 = __builtin_amdgcn_mfma_f32_32x32x16_bf16(kb1_, qf[1], p1, 0, 0, 0); NSA_KLD(kb0_, kb1_, 3); NSA_SB(); \
        p0 = __builtin_amdgcn_mfma_f32_32x32x16_bf16(ka0_, qf[2], p0, 0, 0, 0); p1 = __builtin_amdgcn_mfma_f32_32x32x16_bf16(ka1_, qf[2], p1, 0, 0, 0); NSA_SB(); \
        p0 = __builtin_amdgcn_mfma_f32_32x32x16_bf16(kb0_, qf[3], p0, 0, 0, 0); p1 = __builtin_amdgcn_mfma_f32_32x32x16_bf16(kb1_, qf[3], p1, 0, 0, 0); } while (0)
#define NSA_VTR(p_) __builtin_bit_cast(v2u, __builtin_amdgcn_ds_read_tr16_b64_v4i16((LAS v4i16_t*)(p_)))
#define NSA_VLD(lo_, hi_, k_) do { const LAS unsigned char* vp_ = vb_ + (16 * ((k_) >> 1)) * V_ROW + ((k_) & 1) * 64; lo_ = NSA_VTR(vp_); hi_ = NSA_VTR(vp_ + 8 * V_ROW); } while (0)
#define NSA_PV_PRE(buf) const LAS unsigned char* vb_ = L + VB_OFF + (buf) * VB_SZ + vtoff; v2u vl0_, vh0_, vl1_, vh1_; NSA_VLD(vl0_, vh0_, 0); NSA_VLD(vl1_, vh1_, 1); NSA_SB()
#define NSA_PV_MAIN() do { \
        _Pragma("unroll") for (int g_ = 0; g_ < 4; ++g_) { v4u pw_; \
            if (g_ < 2) { pw_.x = pg8::cvt_pk_bf16(p0[8 * (g_ & 1) + 0], p0[8 * (g_ & 1) + 1]); pw_.y = pg8::cvt_pk_bf16(p0[8 * (g_ & 1) + 2], p0[8 * (g_ & 1) + 3]); pw_.z = pg8::cvt_pk_bf16(p0[8 * (g_ & 1) + 4], p0[8 * (g_ & 1) + 5]); pw_.w = pg8::cvt_pk_bf16(p0[8 * (g_ & 1) + 6], p0[8 * (g_ & 1) + 7]); } \
            else { pw_.x = pg8::cvt_pk_bf16(p1[8 * (g_ & 1) + 0], p1[8 * (g_ & 1) + 1]); pw_.y = pg8::cvt_pk_bf16(p1[8 * (g_ & 1) + 2], p1[8 * (g_ & 1) + 3]); pw_.z = pg8::cvt_pk_bf16(p1[8 * (g_ & 1) + 4], p1[8 * (g_ & 1) + 5]); pw_.w = pg8::cvt_pk_bf16(p1[8 * (g_ & 1) + 6], p1[8 * (g_ & 1) + 7]); } \
            const bf16x8 pf_ = __builtin_bit_cast(bf16x8, pw_); \
            o0 = __builtin_amdgcn_mfma_f32_32x32x16_bf16(__builtin_bit_cast(bf16x8, (v4u){vl0_.x, vl0_.y, vh0_.x, vh0_.y}), pf_, o0, 0, 0, 0); if (g_ < 3) NSA_VLD(vl0_, vh0_, 2 * g_ + 2); NSA_SB(); \
            o1 = __builtin_amdgcn_mfma_f32_32x32x16_bf16(__builtin_bit_cast(bf16x8, (v4u){vl1_.x, vl1_.y, vh1_.x, vh1_.y}), pf_, o1, 0, 0, 0); if (g_ < 3) NSA_VLD(vl1_, vh1_, 2 * g_ + 3); NSA_SB(); } } while (0)
#define NSA_MASK(lim_, lo_) do { \
        _Pragma("unroll") for (int r = 0; r < 16; ++r) { const int c_ = (r & 3) + 8 * (r >> 2); \
            p0[r] = (c_ <= (lim_) && c_ > (lo_)) ? p0[r] : NEGV; p1[r] = (c_ + 32 <= (lim_) && c_ + 32 > (lo_)) ? p1[r] : NEGV; } } while (0)
#define NSA_ROWMAX(mx_) do { float a_ = max3(p0[0], p1[0], p0[1]), b_ = max3(p0[8], p1[8], p0[9]); a_ = max3(a_, p1[1], p0[2]); b_ = max3(b_, p1[9], p0[10]); \
        a_ = max3(a_, p1[2], p0[3]); b_ = max3(b_, p1[10], p0[11]); a_ = max3(a_, p1[3], p0[4]); b_ = max3(b_, p1[11], p0[12]); a_ = max3(a_, p1[4], p0[5]); b_ = max3(b_, p1[12], p0[13]); \
        a_ = max3(a_, p1[5], p0[6]); b_ = max3(b_, p1[13], p0[14]); a_ = max3(a_, p1[6], p0[7]); b_ = max3(b_, p1[14], p0[15]); a_ = max3(a_, p1[7], p1[15]); mx_ = both_max(max3(a_, b_, b_)); } while (0)
#define EREF() ((m_run > -1e29f) ? m_run : 0.f)
#define NSA_ONLINE(WITH_O, mx_) do { const bool val_ = m_run > -1e29f; const bool sh_ = val_ ? ((mx_) > 0.f) : ((mx_) > -1e29f); \
        if (__any(sh_)) { const float dl_ = sh_ ? (mx_) : 0.f; const float alpha_ = val_ ? fast_exp2(-dl_) : 0.f; l_run *= alpha_; m_run = sh_ ? ((val_ ? m_run : 0.f) + dl_) : m_run; \
            _Pragma("unroll") for (int r = 0; r < 16; ++r) { p0[r] -= dl_; p1[r] -= dl_; } \
            if (WITH_O) { _Pragma("unroll") for (int r = 0; r < 16; ++r) { o0[r] *= alpha_; o1[r] *= alpha_; } } } \
        f32x2 ls2_ = (f32x2){0.f, 0.f}; _Pragma("unroll") for (int r = 0; r < 16; r += 2) { p0[r] = fast_exp2(p0[r]); p0[r + 1] = fast_exp2(p0[r + 1]); p1[r] = fast_exp2(p1[r]); p1[r + 1] = fast_exp2(p1[r + 1]); \
            ls2_ += (f32x2){p0[r], p0[r + 1]}; ls2_ += (f32x2){p1[r], p1[r + 1]}; } \
        l_run += ls2_[0] + ls2_[1]; } while (0)
#define NSA_SKIPPABLE(mx_) __all((m_run > -1e29f) ? ((mx_) <= -SKIP) : ((mx_) < -1e29f))
#define NXT(x_) (((x_) == NBUF - 1) ? 0 : (x_) + 1)
#ifdef PROBE_KNOB
#define KNOB_KMX(...) if (!(P.knob & 128)) { __VA_ARGS__ }
#define KNOB_PV(...) if (!(P.knob & 32)) { __VA_ARGS__ }
#define KNOB_EXP(...) if (!(P.knob & 64)) { __VA_ARGS__ }
#else
#define KNOB_PV(...) __VA_ARGS__
#define KNOB_KMX(...) __VA_ARGS__
#define KNOB_EXP(...) __VA_ARGS__
#endif
#define NSA_BOUNDSKIP(buf, slm_, cb_, nov_) ({ const f32x4_t kx_ = *(const LAS f32x4_t*)(L + KMX_OFF + (buf) * 16); const float km_ = fmaxf(fmaxf(kx_[0], kx_[1]), fmaxf(kx_[2], kx_[3])); \
        const float ub_ = __builtin_amdgcn_sqrtf(qn2 * km_) + fmaf((slm_), 63.f, (cb_)) + 0.01f; __all((m_run > -1e29f) ? (ub_ <= -SKIP) : (nov_)); })
    constexpr float SKIP = 30.f;
    f32x16 p0, p1, o0, o1;
    LAS float* OA = (LAS float*)(L + OA_OFF) + tid;
    float m_run, l_run;

    const int nkt = (t0 >> 10) + 1;
    const int cmaxv = (t - 31) >> 4;
    const bf16* kcb = kcmp + (size_t)bg * 512 * 64; const bf16* vcb = vcmp + (size_t)bg * 512 * 64;
    const bf16* ksb = proj1 + (size_t)b * T * N1 + 1280 + g * 64; const bf16* vsb = proj1 + (size_t)b * T * N1 + 1408 + g * 64;
    const bf16* kwb = proj1 + (size_t)b * T * N1 + 1536 + g * 64; const bf16* vwb = proj1 + (size_t)b * T * N1 + 1664 + g * 64;
    const int jhi = t0 >> 6;
    const int cfull = (t0 - 31) >> 4;
    const float slmc = 16.f * sl2;
    int cb = cbio;
    if (first) { cb = 0; NSA_LOAD(kcb + (size_t)(nkt - 1) * 4096, vcb + (size_t)(nkt - 1) * 4096, 64); NSA_WRITE(0); __syncthreads(); }
#ifdef PROBE_KNOB
#define NKT_RUN ((P.knob & 4) ? 0 : nkt)
#else
#define NKT_RUN nkt
#endif
    m_run = NEGV; l_run = 0.f;
    for (int i = NKT_RUN - 1; i >= 0; --i) {
        const int nx = (i > 0) ? i - 1 : nkt - 1;
        NSA_LOAD(kcb + (size_t)nx * 4096, vcb + (size_t)nx * 4096, 64);
        { const float cbv = sl2 * (float)(1024 * i + 31 - t) + slmc * (float)(4 * hi) - EREF();
          if (!NSA_BOUNDSKIP(cb, slmc, cbv, cmaxv < 64 * i)) {
            NSA_QK(cb, slmc, cbv);
            if (64 * i + 63 > cfull) { const int lim = cmaxv - 64 * i - 4 * hi; NSA_MASK(lim, -100000); }
            float mx; NSA_ROWMAX(mx); if (!NSA_SKIPPABLE(mx)) NSA_ONLINE(false, mx); } }
        NSA_WRITE(NXT(cb));
        __syncthreads(); cb = NXT(cb);
    }
    const float ltot = both_sum(l_run); const float adjc = (m_run > -1e29f) ? (-m_run - __builtin_amdgcn_logf(ltot)) : NEGV;
    o0 = f32x16{}; o1 = f32x16{};
    const unsigned short graw0 = NSA_GATE_LD(0);
    for (int i = NKT_RUN - 1; i >= 0; --i) {
        if (i > 0) NSA_LOAD(kcb + (size_t)(i - 1) * 4096, vcb + (size_t)(i - 1) * 4096, 64);
        else NSA_LOAD(ksb + (size_t)jhi * 64 * N1, vsb + (size_t)jhi * 64 * N1, N1);
        const float cbv = sl2 * (float)(1024 * i + 31 - t) + slmc * (float)(4 * hi) + adjc;
        bool skp; { const f32x4_t kx_ = *(const LAS f32x4_t*)(L + KMX_OFF + cb * 16); const float km_ = fmaxf(fmaxf(kx_[0], kx_[1]), fmaxf(kx_[2], kx_[3]));
                    skp = __all(__builtin_amdgcn_sqrtf(qn2 * km_) + fmaf(slmc, 63.f, cbv) + 0.01f <= -SKIP); }
        if (!skp) {
            NSA_QK(cb, slmc, cbv);
            if (64 * i + 63 > cfull) { const int lim = cmaxv - 64 * i - 4 * hi; NSA_MASK(lim, -100000); }
            float mxn; NSA_ROWMAX(mxn); skp = __all(mxn <= -SKIP); }
        LAS float* it_ = IMPT + (w * 32 + r32) * IMPT_LD + hi;
        if (skp) {
#pragma unroll
            for (int q = 0; q < 8; ++q) it_[2 * q] = 0.f;
            if (hi == 0) it_[16] = 0.f;
        } else {
          NSA_PV_PRE(cb);
#pragma unroll
          for (int r = 0; r < 16; ++r) { p0[r] = fast_exp2(p0[r]); p1[r] = fast_exp2(p1[r]); }
          float mainv[2][4], cr[2][4];
#pragma unroll
          for (int rr = 0; rr < 4; ++rr) { mainv[0][rr] = p0[4 * rr] + p0[4 * rr + 1] + p0[4 * rr + 2] + 0.5f * p0[4 * rr + 3]; cr[0][rr] = partner(0.5f * p0[4 * rr + 3]);
                                           mainv[1][rr] = p1[4 * rr] + p1[4 * rr + 1] + p1[4 * rr + 2] + 0.5f * p1[4 * rr + 3]; cr[1][rr] = partner(0.5f * p1[4 * rr + 3]); }
#pragma unroll
          for (int pp = 0; pp < 2; ++pp)
#pragma unroll
              for (int rr = 0; rr < 4; ++rr) { const float prev = (rr > 0) ? cr[pp][rr - 1] : (pp ? cr[0][3] : 0.f); mainv[pp][rr] += hi ? cr[pp][rr] : prev; }
#pragma unroll
          for (int pp = 0; pp < 2; ++pp)
#pragma unroll
              for (int rr = 0; rr < 4; ++rr) it_[8 * pp + 2 * rr] = mainv[pp][rr];
          if (hi == 0) it_[16] = cr[1][3];
          NSA_PV_MAIN();
        }
        NSA_WRITE(NXT(cb));
        __syncthreads(); cb = NXT(cb);
        { const int tok_ = tid >> 4, sl_ = tid & 15; float s_ = 0.f;
#pragma unroll
          for (int hd = 0; hd < 8; ++hd) s_ += IMPT[(hd * 32 + tok_) * IMPT_LD + sl_];
          IMP[tok_ * IMP_LD + 16 * i + sl_] += s_;
          if (tid < 32) { float c_ = 0.f;
#pragma unroll
              for (int hd = 0; hd < 8; ++hd) c_ += IMPT[(hd * 32 + tid) * IMPT_LD + 16];
              IMP[tid * IMP_LD + 16 * (i + 1)] += c_; } }
        __syncthreads();
    }
    { const float gate0 = NSA_GATE(graw0);
#pragma unroll
      for (int r = 0; r < 16; ++r) { OA[r * 512] = gate0 * o0[r]; OA[(16 + r) * 512] = gate0 * o1[r]; } }

    {
        int lane2 = lane; asm volatile("" : "+v"(lane2));
        const int tokq = lane2 >> 4, l16 = lane2 & 15, tokn = w * 4 + tokq, tq = t0 + tokn, cur = tq >> 6;
        unsigned m0 = 0u, m1 = 0u, m2 = 0u, m3 = 0u;
#ifdef PROBE_KNOB
        if (((((t0 + 31) >> 6) + 1) <= 16) || (P.knob & 8)) {
#else
        if ((((t0 + 31) >> 6) + 1) <= 16) {
#endif
            const unsigned long long ml = (1ull << (cur + 1)) - 1ull; m0 = (unsigned)ml; m1 = (unsigned)(ml >> 32);
        } else {
            unsigned key[8];
#pragma unroll
            for (int k = 0; k < 8; ++k) { const int blk = l16 + 16 * k; const float x = fmaxf(IMP[tokn * IMP_LD + blk], 0.f);
                key[k] = (blk > cur || blk == 0 || blk == cur || blk == cur - 1) ? 0u : ((__builtin_bit_cast(unsigned, x) & ~127u) | (unsigned)(127 - blk)); }
            unsigned long long mlo = 1ull, mhi = 0ull;
#define NSA_SETBIT(b_) do { const unsigned long long bit_ = 1ull << ((b_) & 63); mlo |= ((b_) < 64) ? bit_ : 0ull; mhi |= ((b_) < 64) ? 0ull : bit_; } while (0)
            NSA_SETBIT(cur); NSA_SETBIT(cur - 1);
#define NSA_DPPU(x, CTRL) (unsigned)__builtin_amdgcn_mov_dpp((int)(x), (CTRL), 0xf, 0xf, true)
            for (int it = 0; it < 13; ++it) {
                unsigned lm = max(max(max(key[0], key[1]), max(key[2], key[3])), max(max(key[4], key[5]), max(key[6], key[7])));
                lm = max(lm, NSA_DPPU(lm, 0xB1)); lm = max(lm, NSA_DPPU(lm, 0x4E)); lm = max(lm, NSA_DPPU(lm, 0x141)); lm = max(lm, NSA_DPPU(lm, 0x128));
                const int blk = 127 - (int)(lm & 127u);
                NSA_SETBIT(blk);
#pragma unroll
                for (int k = 0; k < 8; ++k) key[k] = (key[k] == lm) ? 0u : key[k];
            }
#undef NSA_DPPU
#undef NSA_SETBIT
            m0 = (unsigned)mlo; m1 = (unsigned)(mlo >> 32); m2 = (unsigned)mhi; m3 = (unsigned)(mhi >> 32);
        }
        if (l16 == 0) *(LAS v4u*)(L + SELM_OFF + tokn * 16) = (v4u){m0, m1, m2, m3};
    }
    __syncthreads();
    if (w == 0) {
        unsigned long long ulo = 0ull, uhi = 0ull, alo = ~0ull, ahi = ~0ull;
        for (int q = 0; q < 32; ++q) { const v4u sm = *(const LAS v4u*)(L + SELM_OFF + q * 16); const unsigned long long a = ((unsigned long long)sm.y << 32) | sm.x, c = ((unsigned long long)sm.w << 32) | sm.z;
            ulo |= a; uhi |= c; alo &= a; ahi &= c; }
        LAS int* UL = (LAS int*)(L + UL_OFF); const int nlo = __builtin_popcountll(ulo);
        if ((ulo >> lane) & 1ull) UL[1 + __builtin_amdgcn_mbcnt_hi((unsigned)(ulo >> 32), __builtin_amdgcn_mbcnt_lo((unsigned)ulo, 0u))] = lane;
        if ((uhi >> lane) & 1ull) UL[1 + nlo + __builtin_amdgcn_mbcnt_hi((unsigned)(uhi >> 32), __builtin_amdgcn_mbcnt_lo((unsigned)uhi, 0u))] = 64 + lane;
        if (lane == 0) { UL[0] = nlo + __builtin_popcountll(uhi); *(LAS v4u*)(L + SELM_OFF + 32 * 16) = (v4u){(unsigned)alo, (unsigned)(alo >> 32), (unsigned)ahi, (unsigned)(ahi >> 32)}; }
    }
    __syncthreads();

    {
        const LAS unsigned* SELW = (const LAS unsigned*)(L + SELM_OFF);
#ifdef PROBE_KNOB
        const LAS int* UL = (const LAS int*)(L + UL_OFF); const int nsel = (P.knob & 2) ? 0 : ((P.knob & 16) ? min(__builtin_amdgcn_readfirstlane(UL[0]), 16) : __builtin_amdgcn_readfirstlane(UL[0]));
#else
        const LAS int* UL = (const LAS int*)(L + UL_OFF); const int nsel = __builtin_amdgcn_readfirstlane(UL[0]);
#endif
        m_run = NEGV; l_run = 0.f; o0 = f32x16{}; o1 = f32x16{};
        const unsigned short graw1 = NSA_GATE_LD(1);
        int jn = jhi;
        for (int i = 0; i < nsel; ++i) {
            const int j = jn;
            if (i + 1 < nsel) { jn = __builtin_amdgcn_readfirstlane(UL[nsel - 1 - i]); NSA_LOAD(ksb + (size_t)jn * 64 * N1, vsb + (size_t)jn * 64 * N1, N1); }
            else NSA_LOAD(kwb + (size_t)jhi * 64 * N1, vwb + (size_t)jhi * 64 * N1, N1);
            { const bool mysel = ((SELW[r32 * 4 + (j >> 5)] >> (j & 31)) & 1u) != 0u; const float cbv = mysel ? (sl2 * (float)(64 * j - t + 4 * hi) - EREF()) : NEGV;
              if (!NSA_BOUNDSKIP(cb, sl2, cbv, !mysel)) {
                NSA_QK(cb, sl2, cbv);
                if (j == jhi) { int lim = t - 64 * j - 4 * hi; asm volatile("" : "+v"(lim)); NSA_MASK(lim, -100000); }
                float mx; NSA_ROWMAX(mx);
                if (!NSA_SKIPPABLE(mx)) { NSA_PV_PRE(cb); KNOB_EXP(NSA_ONLINE(true, mx);) KNOB_PV(NSA_PV_MAIN();) } } }
            NSA_WRITE(NXT(cb));
            __syncthreads(); cb = NXT(cb);
        }
        const float il = NSA_GATE(graw1) * fast_rcp(both_sum(l_run));
#pragma unroll
        for (int r = 0; r < 16; ++r) { OA[r * 512] += il * o0[r]; OA[(16 + r) * 512] += il * o1[r]; }
    }
    {
#ifdef PROBE_KNOB
        const int jlo = (t0 >= 511) ? ((t0 - 511) >> 6) : 0, nw = (P.knob & 1) ? 0 : jhi - jlo + 1;
#else
        const int jlo = (t0 >= 511) ? ((t0 - 511) >> 6) : 0, nw = jhi - jlo + 1;
#endif
        m_run = NEGV; l_run = 0.f; o0 = f32x16{}; o1 = f32x16{};
        const unsigned short graw2 = NSA_GATE_LD(2);
        for (int i = 0; i < nw; ++i) {
            const int j = jhi - i;
            if (i + 1 < nw) NSA_LOAD(kwb + (size_t)(j - 1) * 64 * N1, vwb + (size_t)(j - 1) * 64 * N1, N1);
            else if (nbg >= 0) { const int nk_ = (ntt * 32) >> 10; NSA_LOAD(kcmp + ((size_t)nbg * 512 + 64 * nk_) * 64, vcmp + ((size_t)nbg * 512 + 64 * nk_) * 64, 64); }
            { const float cbv = sl2 * (float)(64 * j - t + 4 * hi) - EREF();
              if (!NSA_BOUNDSKIP(cb, sl2, cbv, false)) {
                NSA_QK(cb, sl2, cbv);
                if (!((64 * j + 63 <= t0) && (64 * j > t0 + 31 - 512))) { int lim = t - 64 * j - 4 * hi; asm volatile("" : "+v"(lim)); NSA_MASK(lim, lim - 512); }
                float mx; NSA_ROWMAX(mx);
                if (!NSA_SKIPPABLE(mx)) { NSA_PV_PRE(cb); KNOB_EXP(NSA_ONLINE(true, mx);) KNOB_PV(NSA_PV_MAIN();) } } }
            if (i + 1 < nw || nbg >= 0) NSA_WRITE(NXT(cb));
            __syncthreads(); cb = NXT(cb);
        }
        const float il = NSA_GATE(graw2) * fast_rcp(both_sum(l_run));
        bf16* op = ocat + row * D + hq * 64 + 4 * hi;
#pragma unroll
        for (int rr = 0; rr < 4; ++rr) { float a[4], c[4];
#pragma unroll
            for (int e = 0; e < 4; ++e) { a[e] = OA[(4 * rr + e) * 512] + il * o0[4 * rr + e]; c[e] = OA[(16 + 4 * rr + e) * 512] + il * o1[4 * rr + e]; }
            *(GAS v2u*)(op + 8 * rr) = (v2u){pg8::cvt_pk_bf16(a[0], a[1]), pg8::cvt_pk_bf16(a[2], a[3])};
            *(GAS v2u*)(op + 32 + 8 * rr) = (v2u){pg8::cvt_pk_bf16(c[0], c[1]), pg8::cvt_pk_bf16(c[2], c[3])}; }
    }
    cbio = cb;
#undef NSA_GATE
#undef NSA_GATE_LD
#undef NSA_LOAD
#undef NSA_WRITE
#undef NSA_QK
#undef NSA_PV_PRE
#undef NSA_PV_MAIN
#undef NSA_VLD
#undef NSA_KLD
#undef NSA_SB
#undef NSA_VTR
#undef NSA_MASK
#undef NSA_ONLINE
#undef NSA_SKIPPABLE
#undef NSA_BOUNDSKIP
#undef EREF
#undef NSA_ROWMAX
#undef NXT
}
}

constexpr int N_PHASES = 20;
__global__ void __launch_bounds__(NTHR, 2) fwd_kernel(Ptrs P) {
    extern __shared__ __attribute__((aligned(16))) unsigned char lds[];
    Frame F;
    F.lds = (LAS unsigned char*)lds;
    F.tid = threadIdx.x; F.lane = F.tid & 63; F.wave = __builtin_amdgcn_readfirstlane(F.tid >> 6);
    F.G = gridDim.x; { const int bx = blockIdx.x; F.vcu = (F.G % 8 == 0) ? (bx % 8) * (F.G / 8) + bx / 8 : bx; }
    unsigned char* ws = P.ws;
    volatile LAS unsigned* MISC = (volatile LAS unsigned*)(F.lds + MISC_OFF);
    for (int u = F.tid; u < (LDS_BYTES - LDSCTL_OFF) / 4; u += NTHR) ((LAS unsigned*)(F.lds + LDSCTL_OFF))[u] = 0u;
    __syncthreads();
#if MK_ONE_LAUNCH
    XcdBarrier bar = xcd_barrier_post((unsigned*)(ws + WS_CTL) + 4096, MISC + 8);
#define GRID_BAR() xcd_barrier(bar)
#else
    (void)MISC;
#define GRID_BAR() do { } while (0)
#endif
#ifndef RES_ALIGN
#define RES_ALIGN true
#endif
    const int lo = P.ph_lo, hi = P.ph_hi;
#ifndef DUP_MASK
#define DUP_MASK 0
#endif
#define NREP(k) (((DUP_MASK >> (k)) & 1) ? 2 : 1)
#if PROBE_A >= 0
#define PROBE_STAMP(k) do { if (blockIdx.x == 0 && threadIdx.x == 0) ((unsigned long long*)(P.ws + WS_CTL + 65536))[(k)] = __builtin_amdgcn_s_memrealtime(); } while (0)
#else
#define PROBE_STAMP(k) do { } while (0)
#endif
#define IN(k) (lo <= (k) && (k) < hi)
#define SEAM(k) do { if (IN(k) && IN((k) + 1)) GRID_BAR(); PROBE_STAMP((k) + 1); { int t_ = threadIdx.x; asm volatile("" : "+v"(t_)); F.tid = t_; F.lane = t_ & 63; } } while (0)
    float* stats = (float*)(ws + WS_STATS);
    bf16* hb = (bf16*)(ws + WS_HB); bf16* hid = (bf16*)(ws + WS_BIG); bf16* ocat = (bf16*)(ws + WS_OCAT);

    PROBE_STAMP(0);
    if (IN(0)) { for (int rep = 0; rep < NREP(0); ++rep) p0_prologue(P, F); }
    SEAM(0);
#ifdef PROBE_KNOB
#define STAGGER() do { if (P.knob & 4096) { const int n_ = (F.vcu & 7) * ((P.knob >> 13) & 7); for (int i_ = 0; i_ < n_; ++i_) __builtin_amdgcn_s_sleep(16); } } while (0)
#else
#define STAGGER() do { const int n_ = (F.vcu & 7) * STAGGER_Q; for (int i_ = 0; i_ < n_; ++i_) __builtin_amdgcn_s_sleep(16); } while (0)
#endif
#ifndef STAGGER_Q
#define STAGGER_Q 0
#endif
#ifdef PROBE_KNOB
#define EPI_KNOB P.knob
#else
#define EPI_KNOB 0
#endif
#ifndef UP_ALIGN
#define UP_ALIGN true
#endif
#define FFN_UP(ph, idx) if (IN(ph)) { STAGGER(); \
        pg8::Gemm g{hb, (const bf16*)(ws + WS_WGU) + (size_t)(idx) * (2 * FF) * D, D, D, 64, (size_t)256 * D, 0, D}; pg8::StaticOrder S; S.init(M, 2 * FF, F.G, (int)blockIdx.x); \
        pg8::EpiUp E{hid, stats, F.lds + RS_OFF}; pg8::gemm_phase<pg8::EpiUp, pg8::StaticOrder, UP_ALIGN>(F.lds + RING_OFF, g, S, E); } SEAM(ph)
#define FFN_DOWN(ph, idx, basep) if (IN(ph)) { STAGGER(); \
        pg8::Gemm g{hid, (const bf16*)(ws + WS_WD) + (size_t)(idx) * D * FF, FF, FF, 64, (size_t)256 * FF, 0, FF}; pg8::StaticOrder S; S.init(M, D, F.G, (int)blockIdx.x); \
        pg8::EpiRes E{hb, stats, 0.5f, EPI_KNOB}; pg8::gemm_phase<pg8::EpiRes, pg8::StaticOrder, RES_ALIGN>(F.lds + RING_OFF, g, S, E); } SEAM(ph)
#define OUT_PROJ(ph, wptr) if (IN(ph)) { STAGGER(); \
        pg8::Gemm g{ocat, (const bf16*)(wptr), D, D, 64, (size_t)256 * D, 0, D}; pg8::StaticOrder S; S.init(M, D, F.G, (int)blockIdx.x); \
        pg8::EpiRes E{hb, stats, 1.0f, EPI_KNOB}; pg8::gemm_phase<pg8::EpiRes, pg8::StaticOrder, RES_ALIGN>(F.lds + RING_OFF, g, S, E); } SEAM(ph)

    FFN_UP(1, 0);
#if DUP_MASK & 2
#undef SEAM
#define SEAM(k) do { } while (0)
    FFN_UP(1, 0);
#undef SEAM
#define SEAM(k) do { if (IN(k) && IN((k) + 1)) GRID_BAR(); PROBE_STAMP((k) + 1); { int t_ = threadIdx.x; asm volatile("" : "+v"(t_)); F.tid = t_; F.lane = t_ & 63; } } while (0)
#endif
    FFN_DOWN(2, 0, P.x);
#if DUP_MASK & 8
    if (IN(3)) {
        pg8::Gemm g{hb, (const bf16*)(ws + WS_W0IN), D, D, 64, (size_t)256 * D, 0, D}; pg8::StaticOrder S; S.init(M, N0, F.G, (int)blockIdx.x);
        pg8::EpiProj E{(bf16*)(ws + WS_BIG), N0, stats, F.lds + RS_OFF}; pg8::gemm_phase<pg8::EpiProj, pg8::StaticOrder>(F.lds + RING_OFF, g, S, E); }
#endif
    if (IN(3)) {
        pg8::Gemm g{hb, (const bf16*)(ws + WS_W0IN), D, D, 64, (size_t)256 * D, 0, D}; pg8::StaticOrder S; S.init(M, N0, F.G, (int)blockIdx.x);
        pg8::EpiProj E{(bf16*)(ws + WS_BIG), N0, stats, F.lds + RS_OFF}; pg8::gemm_phase<pg8::EpiProj, pg8::StaticOrder>(F.lds + RING_OFF, g, S, E); }
    if (IN(3) && F.vcu == F.G - 1) { const float* part = (const float*)(ws + WS_MISC); float* bias = (float*)(ws + WS_MISC + 128 * 1024); const int kv = F.tid >> 8, j = F.tid & 255; float s = 0.f;
            for (int ch = 0; ch < 32; ++ch) s += part[(kv * 32 + ch) * 256 + j];
            bias[F.tid] = s; }
    SEAM(3);
    if (IN(4)) {
        { GlaIn cur, nxt; int u = F.vcu; if (u < 2048) gla_g1_load(P, F, u, cur);
          for (; u < 2048; u += F.G) { const bool hn = u + F.G < 2048; if (hn) gla_g1_load(P, F, u + F.G, nxt); gla_g1_unit(P, F, u, cur); if (hn) cur = nxt; } }
    }
    SEAM(4);
    if (IN(5)) { if (F.tid < 256) gla_g2(P, F); else pool_phase(P, F, F.tid - 256, 256); }
    SEAM(5);
    if (IN(6)) { GlaIn cur, nxt; int u = F.vcu; if (u < 2048) gla_g3_load(P, F, u, cur);
        f32x4 gnr[4]; { const float* gn = P.a_gla_norm + 32 * (F.wave & 3) + 4 * (F.lane >> 5);
#pragma unroll
          for (int rr = 0; rr < 4; ++rr) gnr[rr] = *(const f32x4*)(gn + 8 * rr); }
        for (; u < 2048; u += F.G) { const bool hn = u + F.G < 2048; if (hn) gla_g3_load(P, F, u + F.G, nxt); gla_g3_unit(P, F, u, cur, gnr); if (hn) cur = nxt; } }
    SEAM(6);
#if DUP_MASK & 128
    if (IN(7)) { pg8::Gemm g{ocat, (const bf16*)(ws + WS_W0OUT), D, D, 64, (size_t)256 * D, 0, D}; pg8::StaticOrder S; S.init(M, D, F.G, (int)blockIdx.x);
        pg8::EpiRes E{hb, stats, 0.0f}; pg8::gemm_phase<pg8::EpiRes, pg8::StaticOrder, RES_ALIGN>(F.lds + RING_OFF, g, S, E); }
#endif
    OUT_PROJ(7, ws + WS_W0OUT);
    FFN_UP(8, 1);
#if DUP_MASK & 512
    if (IN(9)) { pg8::Gemm g{hid, (const bf16*)(ws + WS_WD) + (size_t)(1) * D * FF, FF, FF, 64, (size_t)256 * FF, 0, FF}; pg8::StaticOrder S; S.init(M, D, F.G, (int)blockIdx.x);
        pg8::EpiRes E{hb, stats, 0.0f}; pg8::gemm_phase<pg8::EpiRes, pg8::StaticOrder, RES_ALIGN>(F.lds + RING_OFF, g, S, E); }
#endif
    FFN_DOWN(9, 1, P.out);
    FFN_UP(10, 2);
    FFN_DOWN(11, 2, P.out);
    if (IN(12)) {
        pg8::Gemm g{hb, (const bf16*)(ws + WS_W1IN), D, D, 64, (size_t)256 * D, 0, D}; pg8::StaticOrder S; S.init(M, N1, F.G, (int)blockIdx.x);
        pg8::EpiProj E{(bf16*)(ws + WS_BIG), N1, stats, F.lds + RS_OFF}; pg8::gemm_phase<pg8::EpiProj, pg8::StaticOrder>(F.lds + RING_OFF, g, S, E); }
    SEAM(12);
    if (IN(13)) {
        pg8::Gemm g{(const bf16*)(ws + WS_BIG), (const bf16*)(ws + WS_WC1), 256, 16 * N1, N1, 0, 1, 2048}; pg8::CmpOrder S{F.G, (int)blockIdx.x};
        pg8::EpiPart E{(bf16*)(ws + WS_OCAT)}; pg8::gemm_phase<pg8::EpiPart, pg8::CmpOrder>(F.lds + RING_OFF, g, S, E);
        if (F.G == 256) cmp2_fused(P, F, (int)blockIdx.x >> 3, (int)blockIdx.x & 7); }
    SEAM(13);
    if (IN(14) && F.G != 256) { for (int rep = 0; rep < NREP(14); ++rep) cmp2_phase(P, F); }
    if (F.G != 256) SEAM(14);
    if (IN(15)) { int cbio = 0;
#ifdef PROBE_KNOB
        if (P.knob & (1 << 20)) { } else if (P.knob & (1 << 21)) { if (F.wave == 4 || F.wave == 5) __builtin_amdgcn_s_setprio(3); else if (F.wave >= 6) __builtin_amdgcn_s_setprio(1); } else
#endif
        if (F.wave >= 4) __builtin_amdgcn_s_setprio(2);
        for (int i = 0; i * F.G + F.vcu < 2048; ++i) { const int u = i * F.G + F.vcu, un = u + F.G;
            nsa::nsa_unit(P, F, u >> 8, ((u & 255) + 32 * (u >> 8)) & 255, (un < 2048) ? (un >> 8) : -1, ((un & 255) + 32 * (un >> 8)) & 255, i == 0, cbio); }
        __builtin_amdgcn_s_setprio(0); }
    SEAM(15);
    OUT_PROJ(16, ws + WS_W1OUT);
    FFN_UP(17, 3);
    if (IN(18)) { STAGGER();
        pg8::Gemm g{hid, (const bf16*)(ws + WS_WD) + (size_t)3 * D * FF, FF, FF, 64, (size_t)256 * FF, 0, FF}; pg8::StaticOrder S; S.init(M, D, F.G, (int)blockIdx.x);
        if (F.G == 256) { pg8::EpiFinal E{hb, stats, 0.5f, P.out, P.final_norm, (unsigned*)(ws + WS_CTL + 131072), F.lds + RS_OFF}; pg8::gemm_phase<pg8::EpiFinal, pg8::StaticOrder>(F.lds + RING_OFF, g, S, E); }
        else { pg8::EpiRes E{hb, stats, 0.5f, EPI_KNOB}; pg8::gemm_phase<pg8::EpiRes, pg8::StaticOrder, RES_ALIGN>(F.lds + RING_OFF, g, S, E); } } SEAM(18);
    if (IN(19) && F.G != 256) { final_norm_phase(P, F); }
#undef IN
#undef SEAM
}

extern "C" void kernel_launch(void* const* d_in, const int* in_sizes, int n_in, void* d_out, int out_size, void* d_ws, size_t ws_size, hipStream_t stream) {
    static int grid = 0;
    if (grid == 0) {
        if (n_in != 25 || in_sizes[0] != M * D || out_size != M * D || ws_size < WS_END) { fprintf(stderr, "kernel_launch: unexpected shapes (n_in %d, in0 %d, out %d, ws %zu)\n", n_in, n_in > 0 ? in_sizes[0] : -1, out_size, ws_size); grid = -1; return; }
        int dev = 0, cus = 0, per_cu = 0;
        if (hipGetDevice(&dev) != hipSuccess || hipDeviceGetAttribute(&cus, hipDeviceAttributeMultiprocessorCount, dev) != hipSuccess) { grid = -1; return; }
        if (hipFuncSetAttribute((const void*)fwd_kernel, hipFuncAttributeMaxDynamicSharedMemorySize, LDS_BYTES) != hipSuccess) { fprintf(stderr, "kernel_launch: hipFuncSetAttribute failed\n"); grid = -1; return; }
        if (hipOccupancyMaxActiveBlocksPerMultiprocessor(&per_cu, (const void*)fwd_kernel, NTHR, LDS_BYTES) != hipSuccess || per_cu < 1) fprintf(stderr, "kernel_launch: occupancy query reports %d\n", per_cu);
        (void)hipGetLastError();
        grid = cus;
    }
    if (grid < 0) return;
    (void)hipMemsetAsync((char*)d_ws + WS_CTL, 0, CTL_ZERO_BYTES, stream);
    Ptrs p{};
    const float** pp = (const float**)&p;
    for (int i = 0; i < 25; ++i) pp[i] = (const float*)d_in[i];
    p.out = (float*)d_out; p.ws = (unsigned char*)d_ws;
#if MK_ONE_LAUNCH
    p.ph_lo = 0; p.ph_hi = N_PHASES;
    hipLaunchKernelGGL(fwd_kernel, dim3(grid), dim3(NTHR), LDS_BYTES, stream, p);
#ifdef PROBE_KNOB
    for (int r_ = 0; r_ < PROBE_N; ++r_) { (void)hipMemsetAsync((char*)d_ws + WS_CTL, 0, CTL_ZERO_BYTES, stream); p.ph_lo = PROBE_LO; p.ph_hi = PROBE_HI; p.knob = PROBE_KNOB; hipLaunchKernelGGL(fwd_kernel, dim3(grid), dim3(NTHR), LDS_BYTES, stream, p); }
#endif
#else
    for (int ph = 0; ph < N_PHASES; ++ph) { p.ph_lo = ph; p.ph_hi = ph + 1; hipLaunchKernelGGL(fwd_kernel, dim3(grid), dim3(NTHR), LDS_BYTES, stream, p); }
#endif
}
```
